# Optimizing an MI355X kernel written in HIP

```python
import math
import jax, jax.numpy as jnp
from jax import lax
import numpy as np

D_MODEL = 1024
BATCH = 8
SEQ = 2048
DEPTH = 1
DEC_BATCH = 128
DEC_SEQ = 8
PAST_LEN = 16384
PAGE_SIZE = 128

D_MIX = D_MODEL
D_REC = D_MIX // 2
D_CONV = D_MIX - D_REC
H_REC = 4
DK = D_REC // H_REC
DV = D_REC // H_REC
CONV_W = 3
D_FF = 4 * D_MODEL
CHUNK = 64
N_MOD = 6
N_IN = 4 * D_REC + 3 * D_CONV
SPLITS = (D_REC, 2 * D_REC, 3 * D_REC, 4 * D_REC,
          4 * D_REC + D_CONV, 4 * D_REC + 2 * D_CONV)
EPS = 1e-6

kernel_name = "hymba_hgrn2_shortconv_adaln_step"


def rms_norm(x):
    xf = x.astype(jnp.float32)
    y = xf * lax.rsqrt(jnp.mean(xf * xf, axis=-1, keepdims=True) + EPS)
    return y.astype(x.dtype)


def hgrn2_chunked(q, k, logf, v, s0):
    b, l, h, dk = q.shape
    dv = v.shape[-1]
    c = math.gcd(l, CHUNK)
    n = l // c
    f32 = jnp.float32
    q = q.astype(f32).reshape(b, n, c, h, dk)
    k = k.astype(f32).reshape(b, n, c, h, dk)
    logf = logf.astype(f32).reshape(b, n, c, h, dk)
    v = v.astype(f32).reshape(b, n, c, h, dv)
    cum = jnp.cumsum(logf, axis=2)
    last = cum[:, :, -1:]
    q_dec = q * jnp.exp(cum)
    k_dec = k * jnp.exp(-cum)
    scores = jnp.einsum("bntHk,bnsHk->bnHts", q_dec, k_dec)
    causal = jnp.tril(jnp.ones((c, c), dtype=bool))
    scores = jnp.where(causal, scores, 0.0)
    o_intra = jnp.einsum("bnHts,bnsHv->bntHv", scores, v)
    k_end = k * jnp.exp(last - cum)
    upd = jnp.einsum("bnsHk,bnsHv->nbHkv", k_end, v)
    decay = jnp.exp(last[:, :, 0]).transpose(1, 0, 2, 3)

    def step(s, inp):
        d, u = inp
        return d[..., None] * s + u, s

    s_fin, s_prev = lax.scan(step, s0.astype(f32), (decay, upd))
    o_inter = jnp.einsum("bntHk,nbHkv->bntHv", q_dec, s_prev)
    o = (o_intra + o_inter).reshape(b, l, h, dv)
    return o, s_fin


def short_conv(u, buf, w):
    l = u.shape[1]
    full = jnp.concatenate([buf.astype(u.dtype), u], axis=1)
    y = w[0] * full[:, 0:l]
    for j in range(1, CONV_W):
        y = y + w[j] * full[:, j:j + l]
    return y, full[:, -(CONV_W - 1):]


def hybrid_layer(x, c, s_rec, s_conv, lb, w_ada, b_ada, w_in, w_conv, g_onorm,
                 w_out, w_up, w_down):
    bsz, l, _ = x.shape
    mod = jax.nn.silu(c) @ w_ada + b_ada
    sh1, sc1, g1, sh2, sc2, g2 = jnp.split(mod[:, None, :], N_MOD, axis=-1)

    h = rms_norm(x) * (1 + sc1) + sh1
    proj = h @ w_in
    q, fz, i, g, gb, gc, hv = jnp.split(proj, SPLITS, axis=-1)

    fz32 = fz.astype(jnp.float32).reshape(bsz, l, H_REC, DK)
    lb_h = lb.reshape(H_REC, DK)
    logf = jnp.log(lb_h + (1.0 - lb_h) * jax.nn.sigmoid(fz32))
    k = (1.0 - lb_h) * jax.nn.sigmoid(-fz32)
    o_rec, s_rec_new = hgrn2_chunked(q.reshape(bsz, l, H_REC, DK), k, logf,
                                     i.reshape(bsz, l, H_REC, DV), s_rec)
    o_rec = o_rec * lax.rsqrt(jnp.mean(o_rec * o_rec, axis=-1, keepdims=True) + EPS)
    o_rec = (o_rec.reshape(bsz, l, D_REC) * g_onorm).astype(x.dtype) * jax.nn.silu(g)

    y_conv, s_conv_new = short_conv(gc * hv, s_conv, w_conv)
    o_conv = gb * y_conv

    mix = jnp.concatenate([o_rec, o_conv], axis=-1) @ w_out
    x = x + g1 * mix

    h2 = rms_norm(x) * (1 + sc2) + sh2
    x = x + g2 * (jnp.square(jax.nn.relu(h2 @ w_up)) @ w_down)
    return x, s_rec_new.astype(s_rec.dtype), s_conv_new.astype(s_conv.dtype)


def setup_inputs(seed: int = 0) -> dict:
    key = jax.random.key(seed)
    ks = jax.random.split(key, 16)
    f32 = jnp.float32
    nrm = lambda k, shp, s: jax.random.normal(k, shp, f32) * s
    return {
        "x_prompt": nrm(ks[0], (BATCH, SEQ, D_MODEL), 1.0),
        "x_sample": nrm(ks[1], (DEC_BATCH, DEC_SEQ, D_MODEL), 1.0),
        "state_rec": nrm(ks[2], (DEPTH, DEC_BATCH, H_REC, DK, DV), 1.0),
        "state_conv": nrm(ks[3], (DEPTH, DEC_BATCH, CONV_W - 1, D_CONV), 1.0),
        "c_prompt": nrm(ks[4], (BATCH, D_MODEL), 1.0),
        "c_sample": nrm(ks[5], (DEC_BATCH, D_MODEL), 1.0),
        "lower_bounds": nrm(ks[6], (DEPTH + 1, D_REC), 0.1),
        "w_ada": nrm(ks[7], (DEPTH, D_MODEL, N_MOD * D_MODEL), 0.5 * D_MODEL ** -0.5),
        "b_ada": nrm(ks[8], (DEPTH, N_MOD * D_MODEL), 0.02),
        "w_in": nrm(ks[9], (DEPTH, D_MODEL, N_IN), D_MODEL ** -0.5),
        "w_conv": nrm(ks[10], (DEPTH, CONV_W, D_CONV), CONV_W ** -0.5),
        "g_onorm": 1.0 + nrm(ks[11], (DEPTH, D_REC), 0.02),
        "w_out": nrm(ks[12], (DEPTH, D_MIX, D_MODEL), D_MIX ** -0.5),
        "w_up": nrm(ks[13], (DEPTH, D_MODEL, D_FF), D_MODEL ** -0.5),
        "w_down": nrm(ks[14], (DEPTH, D_FF, D_MODEL), D_FF ** -0.5),
        "g_final": 1.0 + nrm(ks[15], (D_MODEL,), 0.02),
    }


def reference(x_prompt, x_sample, state_rec, state_conv, c_prompt, c_sample,
              lower_bounds, w_ada, b_ada, w_in, w_conv, g_onorm, w_out, w_up,
              w_down, g_final):
    lbs = jnp.cumsum(jax.nn.softmax(lower_bounds.astype(jnp.float32), axis=0), axis=0)
    xp, xs = x_prompt, x_sample
    rec_p, conv_p, rec_s, conv_s = [], [], [], []
    for layer in range(DEPTH):
        wl = (w_ada[layer], b_ada[layer], w_in[layer], w_conv[layer], g_onorm[layer],
              w_out[layer], w_up[layer], w_down[layer])
        s_rec0 = jnp.zeros((xp.shape[0], H_REC, DK, DV), state_rec.dtype)
        s_conv0 = jnp.zeros((xp.shape[0], CONV_W - 1, D_CONV), state_conv.dtype)
        xp, sr_p, sc_p = hybrid_layer(xp, c_prompt, s_rec0, s_conv0, lbs[layer], *wl)
        xs, sr_s, sc_s = hybrid_layer(xs, c_sample, state_rec[layer], state_conv[layer],
                                      lbs[layer], *wl)
        rec_p.append(sr_p)
        conv_p.append(sc_p)
        rec_s.append(sr_s)
        conv_s.append(sc_s)
    y_prompt = rms_norm(xp) * g_final
    y_sample = rms_norm(xs) * g_final
    new_rec_prompt = jnp.stack(rec_p)
    new_conv_prompt = jnp.stack(conv_p)
    new_rec_sample = jnp.stack(rec_s)
    new_conv_sample = jnp.stack(conv_s)
    return (y_prompt, y_sample, new_rec_prompt, new_conv_prompt, new_rec_sample, new_conv_sample)
```

```cpp
#include <hip/hip_runtime.h>
#include <hip/hip_cooperative_groups.h>
#include <cstdio>
#include <cstdint>
namespace cg = cooperative_groups;

#ifndef ONE_LAUNCH
#define ONE_LAUNCH 1
#endif

#define LAS __attribute__((address_space(3)))
typedef unsigned short bf16_t;
typedef short bf16x8 __attribute__((ext_vector_type(8)));
typedef short s16x4 __attribute__((ext_vector_type(4)));
typedef float f32x4 __attribute__((ext_vector_type(4)));
typedef float f32x2 __attribute__((ext_vector_type(2)));
typedef unsigned u32x4 __attribute__((ext_vector_type(4)));
typedef unsigned u32x2 __attribute__((ext_vector_type(2)));

constexpr int D = 1024, NTP = 16384, NTS = 1024, MT = 17408, NIN = 3584, FF = 4096;
constexpr int NMOD = 6144, NMODR = 136;
constexpr float EPS = 1e-6f;
constexpr size_t O_Y = 0, O_RECP = (size_t)MT * D, O_CONVP = O_RECP + 8 * 4 * 128 * 128, O_RECS = O_CONVP + 8 * 2 * 512, O_CONVS = O_RECS + (size_t)128 * 4 * 128 * 128;
constexpr size_t WS_WIN = 0, WS_WOUT = 7340032, WS_WUP = 9437184, WS_WDN = 17825792, WS_MOD = 26214400, WS_SBF = 29556736, WS_LBS = 29851648;
constexpr size_t WS_H = 30408704, WS_PROJ = 66060288, WS_LOGF = 190840832, WS_ST = 226492416, WS_U = WS_PROJ, WS_END = 260046848;
constexpr int LDS_BYTES = 131072;

__device__ __forceinline__ unsigned pk2(float lo, float hi) { unsigned r; asm("v_cvt_pk_bf16_f32 %0, %1, %2" : "=v"(r) : "v"(lo), "v"(hi)); return r; }
__device__ __forceinline__ float bflo(unsigned w) { return __uint_as_float(w << 16); }
__device__ __forceinline__ float bfhi(unsigned w) { return __uint_as_float(w & 0xffff0000u); }
__device__ __forceinline__ float bf2f(bf16_t b) { return __uint_as_float(((unsigned)b) << 16); }
__device__ __forceinline__ float wave_sum(float v) {
#pragma unroll
    for (int o = 1; o < 64; o <<= 1) v += __shfl_xor(v, o);
    return v;
}
__device__ __forceinline__ float silu_f(float x) { return x * __builtin_amdgcn_rcpf(1.0f + __expf(-x)); }

namespace pg8 {
constexpr int BM = 256, BK = 64, HALF = 128, HTB = HALF * BK * 2, STAGE_BYTES = 8 * HTB, NXCD = 8, WGM = 8;
__host__ __device__ __forceinline__ int lds_byte(int r, int c) { const int st = (r >> 4) * 2 + (c >> 5), rr = r & 15, cc = c & 31, ob = rr * 64 + cc * 2; return st * 1024 + (ob ^ (((ob >> 9) & 1) << 5)); }
__host__ __device__ __forceinline__ void stage_rc(int b, int& R, int& C) { const int st = b / 1024, sb = b % 1024, swz = sb ^ (((sb >> 9) & 1) << 5); R = (st >> 1) * 16 + swz / 64; C = (st & 1) * 32 + (swz % 64) / 2; }
__host__ __device__ __forceinline__ int perm32(int rho) { const int n = rho >> 4, i = rho & 15; return 8 * (i >> 2) + 4 * n + (i & 3); }

struct Unit { int pm, pn; };
struct Gemm { const bf16_t* A; const bf16_t* Bt; int M, N, K; };

struct StaticOrder {
    int nM, nN, nwg, G, c;
    __host__ __device__ void init(int M, int N, int G_, int c_) { nM = M / BM; nN = N / BM; nwg = nM * nN; G = G_; c = c_; }
    __host__ __device__ bool next(int i, Unit& u) const {
        const long L = (long)i * G + c; if (L >= nwg) return false;
        int wgid = (int)L; { const int q = nwg / NXCD, r = nwg % NXCD, xcd = wgid % NXCD, off = wgid / NXCD; wgid = (xcd < r ? xcd * (q + 1) : r * (q + 1) + (xcd - r) * q) + off; }
        const int nig = WGM * nN, gid = wgid / nig, fm = gid * WGM, gsz = (nM - fm) < WGM ? (nM - fm) : WGM;
        u.pm = fm + ((wgid % nig) % gsz); u.pn = (wgid % nig) / gsz; return true;
    }
    __device__ __forceinline__ void a_ready(const Unit&) const {}
    __device__ __forceinline__ void done(const Unit&) const {}
};


template <class Epi, class Sched, bool ALIGN_EPI = false, bool SP2 = false>
__device__ __forceinline__ void gemm_phase(LAS unsigned char* lds, const Gemm g, const Sched& S, const Epi& E) {
    const int tid = threadIdx.x, wid = __builtin_amdgcn_readfirstlane(tid >> 6), lane = tid & 63, wr = wid >> 2, wc = wid & 3, fr = lane & 15, fq = lane >> 4;
    const int K = g.K, nt = K / BK;
    unsigned voffA[2], voffB[2];
#pragma unroll
    for (int i = 0; i < 2; ++i) { int R, C; stage_rc(tid * 16 + i * 8192, R, C); const int Rb = Epi::PERM ? ((R & ~31) + perm32(R & 31)) : R;
        voffA[i] = (unsigned)(R * K + C) * 2u; voffB[i] = (unsigned)(Rb * K + C) * 2u; }
    const size_t kstep = (size_t)(BK * 2);
    const size_t hstep = (size_t)HALF * K * 2;
    const size_t tstep = 2 * hstep;
    const unsigned ldsw = (unsigned)wid * 1024u;
    const int aoff = lds_byte(wr * 64 + fr, fq * 8), boff = lds_byte(wc * 32 + fr, fq * 8);
#define PG8_SA(b, h) (((b) * 2 + (h)) * HTB)
#define PG8_SB(b, h) ((4 + (b) * 2 + (h)) * HTB)
#define PG8_STAGE(bufoff, gbase, voff) do { _Pragma("unroll") for (int _i = 0; _i < 2; ++_i) \
        __builtin_amdgcn_global_load_lds((const unsigned*)((const char*)(gbase) + (voff)[_i]), (LAS unsigned*)(lds + (bufoff) + ldsw + _i * 8192), 16, 0, 0); } while (0)
#define PG8_LDA(dst, b, h) do { _Pragma("unroll") for (int m = 0; m < 4; ++m) _Pragma("unroll") for (int k = 0; k < 2; ++k) dst[m][k] = *(const LAS bf16x8*)(lds + PG8_SA(b, h) + aoff + m * 2048 + k * 1024); } while (0)
#define PG8_LDB(dst, b, h) do { _Pragma("unroll") for (int n = 0; n < 2; ++n) _Pragma("unroll") for (int k = 0; k < 2; ++k) dst[n][k] = *(const LAS bf16x8*)(lds + PG8_SB(b, h) + boff + n * 2048 + k * 1024); } while (0)
#define PG8_MMA(ai, bj, At, Bt) do { __builtin_amdgcn_s_setprio(1); _Pragma("unroll") for (int m = 0; m < 4; ++m) _Pragma("unroll") for (int n = 0; n < 2; ++n) _Pragma("unroll") for (int k = 0; k < 2; ++k) \
        acc[ai][bj][m][n] = __builtin_amdgcn_mfma_f32_16x16x32_bf16(Bt[n][k], At[m][k], acc[ai][bj][m][n], 0, 0, 0); __builtin_amdgcn_s_setprio(0); } while (0)
#define PG8_WAIT_V(n) asm volatile("s_waitcnt vmcnt(" #n ")" ::: "memory")
#define PG8_WAIT_L(n) asm volatile("s_waitcnt lgkmcnt(" #n ")" ::: "memory")
#define PG8_BAR __builtin_amdgcn_s_barrier()
#define PG8_SCHED __builtin_amdgcn_sched_barrier(0)
    Unit cur, nxt; int ui = 0;
    if (!S.next(0, cur)) return;
    f32x4 acc[2][2][4][2];
#pragma unroll
    for (int a = 0; a < 2; ++a)
#pragma unroll
        for (int b = 0; b < 2; ++b)
#pragma unroll
            for (int m = 0; m < 4; ++m)
#pragma unroll
                for (int n = 0; n < 2; ++n) acc[a][b][m][n] = (f32x4){0.f, 0.f, 0.f, 0.f};
    bf16x8 At[4][2], B0[2][2], B1[2][2];
    const char* cA = (const char*)g.A + (size_t)cur.pm * tstep; const char* cB = (const char*)g.Bt + (size_t)cur.pn * tstep;
    S.a_ready(cur);
    if constexpr (SP2) {
        PG8_STAGE(PG8_SB(0, 0), cB, voffB); PG8_STAGE(PG8_SB(0, 1), cB + hstep, voffB); PG8_STAGE(PG8_SA(0, 0), cA, voffA); PG8_STAGE(PG8_SA(0, 1), cA + hstep, voffA);
        if (wr == 1) PG8_BAR;
        PG8_WAIT_V(2); PG8_BAR;
        PG8_STAGE(PG8_SB(1, 0), cB + kstep, voffB); PG8_STAGE(PG8_SA(1, 0), cA + kstep, voffA); PG8_STAGE(PG8_SB(1, 1), cB + hstep + kstep, voffB);
        PG8_WAIT_V(6); PG8_BAR;
    } else {
        PG8_STAGE(PG8_SB(0, 0), cB, voffB); PG8_STAGE(PG8_SA(0, 0), cA, voffA); PG8_STAGE(PG8_SB(0, 1), cB + hstep, voffB); PG8_STAGE(PG8_SA(0, 1), cA + hstep, voffA);
        if (wr == 1) PG8_BAR;
        PG8_WAIT_V(4); PG8_BAR;
        PG8_STAGE(PG8_SB(1, 0), cB + kstep, voffB); PG8_STAGE(PG8_SA(1, 0), cA + kstep, voffA); PG8_STAGE(PG8_SB(1, 1), cB + hstep + kstep, voffB);
        PG8_WAIT_V(6); PG8_BAR;
    }
    for (;;) {
        const bool has_next = S.next(ui + 1, nxt);
        const char* nA = has_next ? (const char*)g.A + (size_t)nxt.pm * tstep : cA; const char* nB = has_next ? (const char*)g.Bt + (size_t)nxt.pn * tstep : cB;
        for (int t = 0; t < nt; t += 2) {
            const bool last = (t == nt - 2);
            const char* a1 = cA + (size_t)(t + 1) * kstep;
            const char* a2 = last ? nA : cA + (size_t)(t + 2) * kstep; const char* b2 = last ? nB : cB + (size_t)(t + 2) * kstep;
            const char* a3 = a2 + kstep; const char* b3 = b2 + kstep;
            if (last && has_next) S.a_ready(nxt);
            if constexpr (SP2) {
            PG8_LDB(B0, 0, 0); PG8_LDB(B1, 0, 1); PG8_SCHED; PG8_LDA(At, 0, 0); PG8_STAGE(PG8_SA(1, 1), a1 + hstep, voffA);
            PG8_WAIT_V(8); PG8_WAIT_L(0); PG8_BAR; PG8_MMA(0, 0, At, B0); PG8_MMA(0, 1, At, B1); PG8_BAR; PG8_SCHED;
            PG8_LDA(At, 0, 1); PG8_STAGE(PG8_SB(0, 0), b2, voffB); PG8_STAGE(PG8_SB(0, 1), b2 + hstep, voffB); PG8_STAGE(PG8_SA(0, 0), a2, voffA);
            PG8_WAIT_V(8); PG8_WAIT_L(0); PG8_BAR; PG8_MMA(1, 0, At, B0); PG8_MMA(1, 1, At, B1); PG8_BAR; PG8_SCHED;
            PG8_LDB(B0, 1, 0); PG8_LDB(B1, 1, 1); PG8_SCHED; PG8_LDA(At, 1, 0); PG8_STAGE(PG8_SA(0, 1), a2 + hstep, voffA);
            PG8_WAIT_V(8); PG8_WAIT_L(0); PG8_BAR; PG8_MMA(0, 0, At, B0); PG8_MMA(0, 1, At, B1); PG8_BAR; PG8_SCHED;
            PG8_LDA(At, 1, 1); PG8_STAGE(PG8_SB(1, 0), b3, voffB); PG8_STAGE(PG8_SB(1, 1), b3 + hstep, voffB); PG8_STAGE(PG8_SA(1, 0), a3, voffA);
            PG8_WAIT_V(8); PG8_WAIT_L(0); PG8_BAR; PG8_MMA(1, 0, At, B0); PG8_MMA(1, 1, At, B1); PG8_BAR; PG8_SCHED;
            } else {
            PG8_LDB(B0, 0, 0); PG8_SCHED; PG8_LDA(At, 0, 0); PG8_STAGE(PG8_SA(1, 1), a1 + hstep, voffA);
            PG8_WAIT_L(8); PG8_BAR; PG8_WAIT_L(0); PG8_MMA(0, 0, At, B0); PG8_BAR; PG8_SCHED;
            PG8_LDB(B1, 0, 1); PG8_STAGE(PG8_SB(0, 0), b2, voffB);
            PG8_BAR; PG8_WAIT_L(0); PG8_MMA(0, 1, At, B1); PG8_BAR;
            PG8_LDA(At, 0, 1); PG8_STAGE(PG8_SA(0, 0), a2, voffA);
            PG8_BAR; PG8_WAIT_L(0); PG8_MMA(1, 0, At, B0); PG8_BAR; PG8_SCHED;
            PG8_STAGE(PG8_SB(0, 1), b2 + hstep, voffB);
            PG8_WAIT_V(6); PG8_BAR; PG8_MMA(1, 1, At, B1); PG8_BAR;
            PG8_LDB(B0, 1, 0); PG8_SCHED; PG8_LDA(At, 1, 0); PG8_STAGE(PG8_SA(0, 1), a2 + hstep, voffA);
            PG8_WAIT_L(8); PG8_BAR; PG8_WAIT_L(0); PG8_MMA(0, 0, At, B0); PG8_BAR; PG8_SCHED;
            PG8_LDB(B1, 1, 1); PG8_STAGE(PG8_SB(1, 0), b3, voffB);
            PG8_BAR; PG8_WAIT_L(0); PG8_MMA(0, 1, At, B1); PG8_BAR;
            PG8_LDA(At, 1, 1); PG8_STAGE(PG8_SA(1, 0), a3, voffA);
            PG8_BAR; PG8_WAIT_L(0); PG8_MMA(1, 0, At, B0); PG8_BAR; PG8_SCHED;
            PG8_STAGE(PG8_SB(1, 1), b3 + hstep, voffB);
            PG8_WAIT_V(6); PG8_BAR; PG8_MMA(1, 1, At, B1); PG8_BAR;
            }
        }
        if constexpr (ALIGN_EPI) { if (wr == 0) PG8_BAR; }
        E(acc, cur, wr, wc, fr, fq); S.done(cur);
        if (!has_next) break;
#pragma unroll
        for (int a = 0; a < 2; ++a)
#pragma unroll
            for (int b = 0; b < 2; ++b)
#pragma unroll
                for (int m = 0; m < 4; ++m)
#pragma unroll
                    for (int n = 0; n < 2; ++n) acc[a][b][m][n] = (f32x4){0.f, 0.f, 0.f, 0.f};
        cur = nxt; cA = nA; cB = nB; ++ui;
        if constexpr (ALIGN_EPI) { if (wr == 1) PG8_BAR; }
    }
    PG8_WAIT_V(0);
    if constexpr (!ALIGN_EPI) { if (wr == 0) PG8_BAR; }
    PG8_BAR;
#undef PG8_SA
#undef PG8_SB
#undef PG8_STAGE
#undef PG8_LDA
#undef PG8_LDB
#undef PG8_MMA
#undef PG8_WAIT_V
#undef PG8_WAIT_L
#undef PG8_BAR
#undef PG8_SCHED
}
}

struct EpiIn {
    static constexpr bool PERM = true;
    bf16_t* proj; float* logf; const float* lbs;
    __device__ __forceinline__ void operator()(const f32x4 (&acc)[2][2][4][2], const pg8::Unit& u, int wr, int wc, int fr, int fq) const {
        const int row0 = u.pm * 256 + wr * 64 + fr, colt = u.pn * 256 + wc * 32 + 8 * fq;
        const bool isf = (u.pn >> 1) == 1;
        if (!isf) {
#pragma unroll
            for (int ai = 0; ai < 2; ++ai)
#pragma unroll
                for (int m = 0; m < 4; ++m) { bf16_t* rowp = proj + (size_t)(row0 + ai * 128 + m * 16) * NIN + colt;
#pragma unroll
                    for (int bj = 0; bj < 2; ++bj) { const f32x4 v0 = acc[ai][bj][m][0], v1 = acc[ai][bj][m][1];
                        u32x4 w; w.x = pk2(v0[0], v0[1]); w.y = pk2(v0[2], v0[3]); w.z = pk2(v1[0], v1[1]); w.w = pk2(v1[2], v1[3]);
                        *(u32x4*)(rowp + bj * 128) = w; } }
        } else {
#pragma unroll
            for (int bj = 0; bj < 2; ++bj) {
                const int col = colt + bj * 128 - 512;
                const f32x4 lb0 = *(const f32x4*)(lbs + col), lb1 = *(const f32x4*)(lbs + col + 4);
#pragma unroll
                for (int ai = 0; ai < 2; ++ai)
#pragma unroll
                    for (int m = 0; m < 4; ++m) { const size_t row = (size_t)(row0 + ai * 128 + m * 16);
                        f32x4 lg[2], kk[2];
#pragma unroll
                        for (int n = 0; n < 2; ++n)
#pragma unroll
                            for (int j = 0; j < 4; ++j) { const float lb = n ? lb1[j] : lb0[j]; float fz = acc[ai][bj][m][n][j]; fz = fminf(fmaxf(fz, -30.f), 30.f);
                                const float e = __expf(-fz), sg = __builtin_amdgcn_rcpf(1.0f + e);
                                lg[n][j] = __logf(lb + (1.0f - lb) * sg); kk[n][j] = (1.0f - lb) * e * sg; }
                        *(f32x4*)(logf + row * 512 + col) = lg[0]; *(f32x4*)(logf + row * 512 + col + 4) = lg[1];
                        u32x4 w; w.x = pk2(kk[0][0], kk[0][1]); w.y = pk2(kk[0][2], kk[0][3]); w.z = pk2(kk[1][0], kk[1][1]); w.w = pk2(kk[1][2], kk[1][3]);
                        *(u32x4*)(proj + row * NIN + colt + bj * 128) = w; }
            }
        }
    }
};
struct EpiRes {
    static constexpr bool PERM = false;
    const float* basep; const float* bases; float* out; const float* gate;
    __device__ __forceinline__ void operator()(const f32x4 (&acc)[2][2][4][2], const pg8::Unit& u, int wr, int wc, int fr, int fq) const {
        const int row0 = u.pm * 256 + wr * 64 + fr, col0 = u.pn * 256 + wc * 32 + 4 * fq;
#pragma unroll
        for (int ai = 0; ai < 2; ++ai)
#pragma unroll
            for (int m = 0; m < 4; ++m) { const int row = row0 + ai * 128 + m * 16;
                const float* bp = row < NTP ? basep + (size_t)row * D : bases + (size_t)(row - NTP) * D;
                const int mb = row < NTP ? (row >> 11) : 8 + ((row - NTP) >> 3);
                const float* gp = gate + (size_t)mb * NMOD + col0; float* op = out + (size_t)row * D + col0;
#pragma unroll
                for (int bj = 0; bj < 2; ++bj)
#pragma unroll
                    for (int n = 0; n < 2; ++n) { const int c = bj * 128 + n * 16;
                        const f32x4 bs = *(const f32x4*)(bp + col0 + c), gv = *(const f32x4*)(gp + c);
                        *(f32x4*)(op + c) = bs + gv * acc[ai][bj][m][n]; }
                asm volatile("" ::: "memory"); }
    }
};
struct EpiUp {
    static constexpr bool PERM = true;
    bf16_t* U;
    __device__ __forceinline__ void operator()(const f32x4 (&acc)[2][2][4][2], const pg8::Unit& u, int wr, int wc, int fr, int fq) const {
        const int row0 = u.pm * 256 + wr * 64 + fr, colt = u.pn * 256 + wc * 32 + 8 * fq;
#pragma unroll
        for (int ai = 0; ai < 2; ++ai)
#pragma unroll
            for (int m = 0; m < 4; ++m) { bf16_t* rowp = U + (size_t)(row0 + ai * 128 + m * 16) * FF + colt;
#pragma unroll
                for (int bj = 0; bj < 2; ++bj) { f32x4 v0 = acc[ai][bj][m][0], v1 = acc[ai][bj][m][1];
#pragma unroll
                    for (int j = 0; j < 4; ++j) { const float a = fmaxf(v0[j], 0.f), b = fmaxf(v1[j], 0.f); v0[j] = a * a; v1[j] = b * b; }
                    u32x4 w; w.x = pk2(v0[0], v0[1]); w.y = pk2(v0[2], v0[3]); w.z = pk2(v1[0], v1[1]); w.w = pk2(v1[2], v1[3]);
                    *(u32x4*)(rowp + bj * 128) = w; } }
    }
};

struct Args { const float* in[16]; float* out; unsigned char* ws; int ph_lo, ph_hi; };

__device__ __forceinline__ void p0_transpose_item(const float* __restrict__ W, int K, int N, bf16_t* __restrict__ WT, LAS float* scr, int item, int lane) {
    const int nblk = N / 32, kb = item / nblk, nb = item % nblk, k0 = 64 * kb, n0 = 32 * nb;
#pragma unroll 8
    for (int i = 0; i < 32; ++i) { const int kk = 2 * i + (lane >> 5); scr[kk * 33 + (lane & 31)] = W[(size_t)(k0 + kk) * N + n0 + (lane & 31)]; }
    asm volatile("s_waitcnt lgkmcnt(0)" ::: "memory");
    const int c = lane & 7;
#pragma unroll
    for (int j = 0; j < 4; ++j) { const int n = (lane >> 3) + 8 * j; const LAS float* s = scr + (8 * c) * 33 + n;
        u32x4 o; o.x = pk2(s[0 * 33], s[1 * 33]); o.y = pk2(s[2 * 33], s[3 * 33]); o.z = pk2(s[4 * 33], s[5 * 33]); o.w = pk2(s[6 * 33], s[7 * 33]);
        *(u32x4*)(WT + (size_t)(n0 + n) * K + k0 + 8 * c) = o; }
    asm volatile("s_waitcnt lgkmcnt(0)" ::: "memory");
}

__device__ __forceinline__ void phase_prep(const Args& a, LAS unsigned char* lds) {
    const int tid = threadIdx.x, lane = tid & 63, wid = __builtin_amdgcn_readfirstlane(tid >> 6);
    LAS float* scr = (LAS float*)(lds + wid * 16384);
    const int gw = blockIdx.x * 8 + wid, NGW = gridDim.x * 8;
    constexpr int I_IN = 16 * 112, I_OUT = 16 * 32, I_UP = 16 * 128, I_DN = 64 * 32, NITEMS = I_IN + I_OUT + I_UP + I_DN;
    for (int it = gw; it < NITEMS; it += NGW) {
        int r = it;
        if (r < I_IN) { p0_transpose_item(a.in[9], D, NIN, (bf16_t*)(a.ws + WS_WIN), scr, r, lane); continue; } r -= I_IN;
        if (r < I_OUT) { p0_transpose_item(a.in[12], D, D, (bf16_t*)(a.ws + WS_WOUT), scr, r, lane); continue; } r -= I_OUT;
        if (r < I_UP) { p0_transpose_item(a.in[13], D, FF, (bf16_t*)(a.ws + WS_WUP), scr, r, lane); continue; } r -= I_UP;
        p0_transpose_item(a.in[14], FF, D, (bf16_t*)(a.ws + WS_WDN), scr, r, lane);
    }
    bf16_t* sbf = (bf16_t*)(a.ws + WS_SBF);
    for (int i = blockIdx.x * 512 + tid; i < NMODR * D / 2; i += gridDim.x * 512) {
        const int e = 2 * i; const float* src = e < 8 * D ? a.in[4] + e : a.in[5] + (e - 8 * D);
        const f32x2 v = *(const f32x2*)src; *(unsigned*)(sbf + e) = pk2(silu_f(v.x), silu_f(v.y));
    }
    float* lbs = (float*)(a.ws + WS_LBS);
    for (int i = blockIdx.x * 512 + tid; i < 512; i += gridDim.x * 512) { const float x0 = a.in[6][i], x1 = a.in[6][512 + i]; lbs[i] = 1.0f / (1.0f + __expf(x1 - x0)); }
}

__device__ __forceinline__ void phase_mod(const Args& a, LAS unsigned char* lds) {
    const int tid = threadIdx.x, lane = tid & 63, wid = __builtin_amdgcn_readfirstlane(tid >> 6), fr = lane & 15, fq = lane >> 4;
    const float* __restrict__ w_ada = a.in[7]; const float* __restrict__ b_ada = a.in[8];
    const bf16_t* sbf = (const bf16_t*)(a.ws + WS_SBF); float* mod = (float*)(a.ws + WS_MOD);
    LAS float* red = (LAS float*)lds;
    for (int item = blockIdx.x; item < 192; item += gridDim.x) {
        const int ntile = item * 2 + (wid >> 2), ks = wid & 3, n0 = ntile * 16, kb = ks * 256;
        f32x4 acc[9];
#pragma unroll
        for (int mt = 0; mt < 9; ++mt) acc[mt] = (f32x4){0.f, 0.f, 0.f, 0.f};
        for (int kk = 0; kk < 8; ++kk) {
            const int k0 = kb + kk * 32 + fq * 8;
            float w[8];
#pragma unroll
            for (int e = 0; e < 8; ++e) w[e] = w_ada[(size_t)(k0 + e) * NMOD + n0 + fr];
            u32x4 bw; bw.x = pk2(w[0], w[1]); bw.y = pk2(w[2], w[3]); bw.z = pk2(w[4], w[5]); bw.w = pk2(w[6], w[7]);
            const bf16x8 bfrag = __builtin_bit_cast(bf16x8, bw);
#pragma unroll
            for (int mt = 0; mt < 9; ++mt) { int row = mt * 16 + fr; row = row > 135 ? 135 : row;
                const bf16x8 afrag = *(const bf16x8*)(sbf + (size_t)row * D + k0);
                acc[mt] = __builtin_amdgcn_mfma_f32_16x16x32_bf16(afrag, bfrag, acc[mt], 0, 0, 0); }
        }
#pragma unroll
        for (int mt = 0; mt < 9; ++mt)
#pragma unroll
            for (int j = 0; j < 4; ++j) red[(wid * 36 + mt * 4 + j) * 64 + lane] = acc[mt][j];
        __syncthreads();
        for (int o = tid; o < 4608; o += 512) {
            const int t = o / 2304, rem = o % 2304, row = rem >> 4, col = rem & 15, mt = row >> 4, r = row & 15, q = r >> 2, j = r & 3, ln = q * 16 + col;
            float s = 0.f;
#pragma unroll
            for (int k2 = 0; k2 < 4; ++k2) s += red[((t * 4 + k2) * 36 + mt * 4 + j) * 64 + ln];
            const int n = (item * 2 + t) * 16 + col;
            if (row < NMODR) mod[(size_t)row * NMOD + n] = s + b_ada[n];
        }
        __syncthreads();
    }
}

__device__ __forceinline__ void phase_norm_mod(const float* src0, const float* src1, const float* mod, int sh_off, int sc_off, bf16_t* out) {
    const int tid = threadIdx.x, lane = tid & 63, wid = __builtin_amdgcn_readfirstlane(tid >> 6);
    const int gw = blockIdx.x * 8 + wid, NGW = gridDim.x * 8;
    for (int row = gw; row < MT; row += NGW) {
        const float* xr = row < NTP ? src0 + (size_t)row * D : src1 + (size_t)(row - NTP) * D;
        const int mb = row < NTP ? (row >> 11) : 8 + ((row - NTP) >> 3);
        const float* mr = mod + (size_t)mb * NMOD;
        f32x4 v[4]; float s = 0.f;
#pragma unroll
        for (int j = 0; j < 4; ++j) { v[j] = *(const f32x4*)(xr + 4 * lane + 256 * j); s += (v[j].x * v[j].x + v[j].y * v[j].y) + (v[j].z * v[j].z + v[j].w * v[j].w); }
        const float rstd = rsqrtf(wave_sum(s) * (1.0f / D) + EPS);
#pragma unroll
        for (int j = 0; j < 4; ++j) { const f32x4 sc = *(const f32x4*)(mr + sc_off + 4 * lane + 256 * j), sh = *(const f32x4*)(mr + sh_off + 4 * lane + 256 * j);
            const f32x4 o = v[j] * rstd * (sc + 1.0f) + sh; u32x2 w; w.x = pk2(o.x, o.y); w.y = pk2(o.z, o.w);
            *(u32x2*)(out + (size_t)row * D + 4 * lane + 256 * j) = w; }
    }
}

__device__ __forceinline__ void phase_final(float* y, const float* gfin) {
    const int tid = threadIdx.x, lane = tid & 63, wid = __builtin_amdgcn_readfirstlane(tid >> 6);
    const int gw = blockIdx.x * 8 + wid, NGW = gridDim.x * 8;
    f32x4 gf[4];
#pragma unroll
    for (int j = 0; j < 4; ++j) gf[j] = *(const f32x4*)(gfin + 4 * lane + 256 * j);
    for (int row = gw; row < MT; row += NGW) {
        float* xr = y + (size_t)row * D;
        f32x4 v[4]; float s = 0.f;
#pragma unroll
        for (int j = 0; j < 4; ++j) { v[j] = *(const f32x4*)(xr + 4 * lane + 256 * j); s += (v[j].x * v[j].x + v[j].y * v[j].y) + (v[j].z * v[j].z + v[j].w * v[j].w); }
        const float rstd = rsqrtf(wave_sum(s) * (1.0f / D) + EPS);
#pragma unroll
        for (int j = 0; j < 4; ++j) *(f32x4*)(xr + 4 * lane + 256 * j) = v[j] * rstd * gf[j];
    }
}

__device__ __forceinline__ bf16x8 tr_frag(LAS unsigned char* base, int stride_bytes, int r0, int c0, int lane) {
    const int g = lane >> 4, q = (lane >> 2) & 3, p = lane & 3;
    LAS unsigned char* a0 = base + (r0 + 8 * g + q) * stride_bytes + (c0 + 4 * p) * 2;
    const s16x4 lo = __builtin_amdgcn_ds_read_tr16_b64_v4i16((LAS s16x4*)a0);
    const s16x4 hi = __builtin_amdgcn_ds_read_tr16_b64_v4i16((LAS s16x4*)(a0 + 4 * stride_bytes));
    bf16x8 r; r[0] = lo[0]; r[1] = lo[1]; r[2] = lo[2]; r[3] = lo[3]; r[4] = hi[0]; r[5] = hi[1]; r[6] = hi[2]; r[7] = hi[3]; return r;
}

__device__ __forceinline__ void scan_item(int item, const Args& a, LAS unsigned char* lds) {
    const int tid = threadIdx.x, lane = tid & 63, wid = __builtin_amdgcn_readfirstlane(tid >> 6), fr = lane & 15, fq = lane >> 4;
    const int b = item >> 4, h = (item >> 2) & 3, ks = item & 3;
    const bf16_t* proj = (const bf16_t*)(a.ws + WS_PROJ); const float* logf = (const float*)(a.ws + WS_LOGF); bf16_t* St = (bf16_t*)(a.ws + WS_ST);
    constexpr int KE_STR = 72, VS_STR = 272, KE_BYTES = 64 * KE_STR, VS_BYTES = 64 * VS_STR;
    LAS unsigned char* KE = lds; LAS unsigned char* VS = lds + 2 * KE_BYTES; LAS float* DEC = (LAS float*)(lds + 2 * KE_BYTES + 2 * VS_BYTES);
    const int vs_s = tid >> 3, vs_ch = tid & 7;
    const size_t rowb = (size_t)b * 2048;
    f32x4 S[2]; S[0] = (f32x4){0.f, 0.f, 0.f, 0.f}; S[1] = S[0];
    f32x4 lf; u32x2 kw; u32x4 vv0, vv1;
    { const size_t r1 = rowb + lane, r2 = rowb + vs_s;
      lf = *(const f32x4*)(logf + r1 * 512 + h * 128 + ks * 32 + 4 * wid);
      kw = *(const u32x2*)(proj + r1 * NIN + 512 + h * 128 + ks * 32 + 4 * wid);
      vv0 = *(const u32x4*)(proj + r2 * NIN + 1024 + h * 128 + vs_ch * 16); vv1 = *(const u32x4*)(proj + r2 * NIN + 1024 + h * 128 + vs_ch * 16 + 8); }
    for (int n = 0; n < 32; ++n) {
        const int buf = n & 1;
        f32x4 c = lf;
#pragma unroll
        for (int d = 1; d < 64; d <<= 1) {
            f32x4 t; t.x = __shfl_up(c.x, d); t.y = __shfl_up(c.y, d); t.z = __shfl_up(c.z, d); t.w = __shfl_up(c.w, d);
            if (lane >= d) c += t;
        }
        f32x4 last; last.x = __shfl(c.x, 63); last.y = __shfl(c.y, 63); last.z = __shfl(c.z, 63); last.w = __shfl(c.w, 63);
        { const float k0 = bflo(kw.x), k1 = bfhi(kw.x), k2 = bflo(kw.y), k3 = bfhi(kw.y);
          u32x2 w; w.x = pk2(k0 * __expf(last.x - c.x), k1 * __expf(last.y - c.y)); w.y = pk2(k2 * __expf(last.z - c.z), k3 * __expf(last.w - c.w));
          *(LAS u32x2*)(KE + buf * KE_BYTES + lane * KE_STR + wid * 8) = w; }
        if (lane == 63) { f32x4 dv; dv.x = __expf(last.x); dv.y = __expf(last.y); dv.z = __expf(last.z); dv.w = __expf(last.w); *(LAS f32x4*)(DEC + buf * 32 + 4 * wid) = dv; }
        *(LAS u32x4*)(VS + buf * VS_BYTES + vs_s * VS_STR + vs_ch * 32) = vv0; *(LAS u32x4*)(VS + buf * VS_BYTES + vs_s * VS_STR + vs_ch * 32 + 16) = vv1;
        if (n + 1 < 32) { const size_t r1 = rowb + (n + 1) * 64 + lane, r2 = rowb + (n + 1) * 64 + vs_s;
            lf = *(const f32x4*)(logf + r1 * 512 + h * 128 + ks * 32 + 4 * wid);
            kw = *(const u32x2*)(proj + r1 * NIN + 512 + h * 128 + ks * 32 + 4 * wid);
            vv0 = *(const u32x4*)(proj + r2 * NIN + 1024 + h * 128 + vs_ch * 16); vv1 = *(const u32x4*)(proj + r2 * NIN + 1024 + h * 128 + vs_ch * 16 + 8); }
        __syncthreads();
        { bf16_t* sp = St + ((size_t)((b * 32 + n) * 4 + h)) * 16384 + (size_t)(16 * wid + fr) * 128 + ks * 32 + 4 * fq;
#pragma unroll
          for (int kt = 0; kt < 2; ++kt) { u32x2 w; w.x = pk2(S[kt][0], S[kt][1]); w.y = pk2(S[kt][2], S[kt][3]); *(u32x2*)(sp + kt * 16) = w; } }
#pragma unroll
        for (int kt = 0; kt < 2; ++kt) { const f32x4 dv = *(const LAS f32x4*)(DEC + buf * 32 + kt * 16 + 4 * fq); S[kt] *= dv; }
#pragma unroll
        for (int ss = 0; ss < 2; ++ss) {
            const bf16x8 bfrag = tr_frag(VS + buf * VS_BYTES, VS_STR, 32 * ss, 16 * wid, lane);
#pragma unroll
            for (int kt = 0; kt < 2; ++kt) { const bf16x8 afrag = tr_frag(KE + buf * KE_BYTES, KE_STR, 32 * ss, 16 * kt, lane);
                S[kt] = __builtin_amdgcn_mfma_f32_16x16x32_bf16(afrag, bfrag, S[kt], 0, 0, 0); }
        }
    }
    float* recp = a.out + O_RECP;
#pragma unroll
    for (int kt = 0; kt < 2; ++kt)
#pragma unroll
        for (int j = 0; j < 4; ++j) recp[((size_t)((b * 4 + h) * 128 + ks * 32 + kt * 16 + 4 * fq + j)) * 128 + 16 * wid + fr] = S[kt][j];
    __syncthreads();
}

__device__ __forceinline__ void sample_pair(int pair, const Args& a, LAS unsigned char* lds) {
    const int tid = threadIdx.x, lane = tid & 63, wid = __builtin_amdgcn_readfirstlane(tid >> 6);
    const int b = pair >> 2, h = pair & 3, v = tid & 127, kg = tid >> 7;
    const bf16_t* proj = (const bf16_t*)(a.ws + WS_PROJ); const float* logf = (const float*)(a.ws + WS_LOGF); bf16_t* mix = (bf16_t*)(a.ws + WS_H);
    LAS float* fT = (LAS float*)lds; LAS float* kT = fT + 1024; LAS float* qT = kT + 1024; LAS float* part = qT + 1024;
    const size_t row0 = (size_t)NTP + b * 8;
#pragma unroll
    for (int i = 0; i < 2; ++i) { const int idx = tid + 512 * i, t = idx >> 7, kk = idx & 127; const size_t row = row0 + t;
        fT[idx] = __expf(logf[row * 512 + h * 128 + kk]); kT[idx] = bf2f(proj[row * NIN + 512 + h * 128 + kk]); qT[idx] = bf2f(proj[row * NIN + h * 128 + kk]); }
    const float* s0 = a.in[2] + ((size_t)((b * 4 + h) * 128 + kg * 32)) * 128 + v;
    float S[32];
#pragma unroll
    for (int j = 0; j < 32; ++j) S[j] = s0[(size_t)j * 128];
    __syncthreads();
#pragma unroll 1
    for (int t = 0; t < 8; ++t) {
        const float vt = bf2f(proj[(row0 + t) * NIN + 1024 + h * 128 + v]);
        float op = 0.f;
#pragma unroll
        for (int j4 = 0; j4 < 8; ++j4) {
            const f32x4 f4 = *(const LAS f32x4*)(fT + t * 128 + kg * 32 + 4 * j4), k4 = *(const LAS f32x4*)(kT + t * 128 + kg * 32 + 4 * j4), q4 = *(const LAS f32x4*)(qT + t * 128 + kg * 32 + 4 * j4);
#pragma unroll
            for (int e = 0; e < 4; ++e) { S[4 * j4 + e] = f4[e] * S[4 * j4 + e] + k4[e] * vt; op += q4[e] * S[4 * j4 + e]; }
        }
        part[(t * 4 + kg) * 128 + v] = op;
    }
    float* s1 = a.out + O_RECS + ((size_t)((b * 4 + h) * 128 + kg * 32)) * 128 + v;
#pragma unroll
    for (int j = 0; j < 32; ++j) s1[(size_t)j * 128] = S[j];
    __syncthreads();
    { const int t = wid; const size_t row = row0 + t;
      float o0 = 0.f, o1 = 0.f;
#pragma unroll
      for (int g = 0; g < 4; ++g) { o0 += part[(t * 4 + g) * 128 + lane]; o1 += part[(t * 4 + g) * 128 + lane + 64]; }
      const float rstd = rsqrtf(wave_sum(o0 * o0 + o1 * o1) * (1.0f / 128.0f) + EPS);
      const float g0 = bf2f(proj[row * NIN + 1536 + h * 128 + lane]), g1 = bf2f(proj[row * NIN + 1536 + h * 128 + lane + 64]);
      const float* gon = a.in[11] + h * 128;
      const unsigned w0 = pk2(o0 * rstd * gon[lane] * silu_f(g0), 0.f), w1 = pk2(o1 * rstd * gon[lane + 64] * silu_f(g1), 0.f);
      mix[row * D + h * 128 + lane] = (bf16_t)(w0 & 0xffffu); mix[row * D + h * 128 + lane + 64] = (bf16_t)(w1 & 0xffffu); }
    __syncthreads();
}

__device__ __forceinline__ void conv_tasks(const Args& a) {
    const int tid = threadIdx.x;
    const bf16_t* proj = (const bf16_t*)(a.ws + WS_PROJ); bf16_t* mix = (bf16_t*)(a.ws + WS_H);
    const float* wconv = a.in[10];
    for (int tt = blockIdx.x * 512 + tid; tt < 2176 * 64; tt += gridDim.x * 512) {
        const int seg = tt >> 6, cgp = tt & 63, c0 = cgp * 8;
        const bool samp = seg >= 2048;
        size_t row0; int pos;
        if (!samp) { row0 = (size_t)seg * 8; pos = (seg * 8) & 2047; } else { row0 = (size_t)NTP + (size_t)(seg - 2048) * 8; pos = 0; }
        float um2[8], um1[8], w0[8], w1[8], w2[8];
        { const f32x4 a0 = *(const f32x4*)(wconv + c0), a1 = *(const f32x4*)(wconv + c0 + 4), b0 = *(const f32x4*)(wconv + 512 + c0), b1 = *(const f32x4*)(wconv + 512 + c0 + 4),
                      d0 = *(const f32x4*)(wconv + 1024 + c0), d1 = *(const f32x4*)(wconv + 1024 + c0 + 4);
#pragma unroll
          for (int e = 0; e < 4; ++e) { w0[e] = a0[e]; w0[4 + e] = a1[e]; w1[e] = b0[e]; w1[4 + e] = b1[e]; w2[e] = d0[e]; w2[4 + e] = d1[e]; } }
        if (samp) { const float* sc = a.in[3] + (size_t)(seg - 2048) * 1024 + c0;
            const f32x4 p0 = *(const f32x4*)sc, p1 = *(const f32x4*)(sc + 4), q0 = *(const f32x4*)(sc + 512), q1 = *(const f32x4*)(sc + 516);
#pragma unroll
            for (int e = 0; e < 4; ++e) { um2[e] = p0[e]; um2[4 + e] = p1[e]; um1[e] = q0[e]; um1[4 + e] = q1[e]; }
        } else if (pos >= 2) {
            const bf16_t* pr = proj + (row0 - 2) * NIN;
            const u32x4 c2 = *(const u32x4*)(pr + 2560 + c0), h2 = *(const u32x4*)(pr + 3072 + c0), c1 = *(const u32x4*)(pr + NIN + 2560 + c0), h1 = *(const u32x4*)(pr + NIN + 3072 + c0);
#pragma unroll
            for (int e = 0; e < 4; ++e) { um2[2 * e] = bflo(c2[e]) * bflo(h2[e]); um2[2 * e + 1] = bfhi(c2[e]) * bfhi(h2[e]); um1[2 * e] = bflo(c1[e]) * bflo(h1[e]); um1[2 * e + 1] = bfhi(c1[e]) * bfhi(h1[e]); }
        } else {
#pragma unroll
            for (int e = 0; e < 8; ++e) { um2[e] = 0.f; um1[e] = 0.f; }
        }
#pragma unroll
        for (int i = 0; i < 8; ++i) {
            const bf16_t* pr = proj + (row0 + i) * NIN;
            const u32x4 bv = *(const u32x4*)(pr + 2048 + c0), cv = *(const u32x4*)(pr + 2560 + c0), hv = *(const u32x4*)(pr + 3072 + c0);
            float u[8], o[8];
#pragma unroll
            for (int e = 0; e < 4; ++e) { u[2 * e] = bflo(cv[e]) * bflo(hv[e]); u[2 * e + 1] = bfhi(cv[e]) * bfhi(hv[e]); }
#pragma unroll
            for (int e = 0; e < 4; ++e) { o[2 * e] = bflo(bv[e]) * (w0[2 * e] * um2[2 * e] + w1[2 * e] * um1[2 * e] + w2[2 * e] * u[2 * e]);
                                          o[2 * e + 1] = bfhi(bv[e]) * (w0[2 * e + 1] * um2[2 * e + 1] + w1[2 * e + 1] * um1[2 * e + 1] + w2[2 * e + 1] * u[2 * e + 1]); }
            u32x4 w; w.x = pk2(o[0], o[1]); w.y = pk2(o[2], o[3]); w.z = pk2(o[4], o[5]); w.w = pk2(o[6], o[7]);
            *(u32x4*)(mix + (row0 + i) * D + 512 + c0) = w;
#pragma unroll
            for (int e = 0; e < 8; ++e) { um2[e] = um1[e]; um1[e] = u[e]; }
        }
        float* cs = nullptr;
        if (samp) cs = a.out + O_CONVS + (size_t)(seg - 2048) * 1024 + c0;
        else if (pos == 2040) cs = a.out + O_CONVP + (size_t)(seg >> 8) * 1024 + c0;
        if (cs) { *(f32x4*)cs = (f32x4){um2[0], um2[1], um2[2], um2[3]}; *(f32x4*)(cs + 4) = (f32x4){um2[4], um2[5], um2[6], um2[7]};
                  *(f32x4*)(cs + 512) = (f32x4){um1[0], um1[1], um1[2], um1[3]}; *(f32x4*)(cs + 516) = (f32x4){um1[4], um1[5], um1[6], um1[7]}; }
    }
}

__device__ __forceinline__ void passc_item(int item, const Args& a, LAS unsigned char* lds) {
    const int tid = threadIdx.x, lane = tid & 63, wid = __builtin_amdgcn_readfirstlane(tid >> 6), fr = lane & 15, fq = lane >> 4;
    const int h = item & 3, n = (item >> 2) & 31, b = item >> 7;
    const bf16_t* proj = (const bf16_t*)(a.ws + WS_PROJ); const float* logf = (const float*)(a.ws + WS_LOGF); const bf16_t* St = (const bf16_t*)(a.ws + WS_ST); bf16_t* mix = (bf16_t*)(a.ws + WS_H);
    constexpr int RS = 272, PS = 144;
    LAS unsigned char* QD = lds; LAS unsigned char* KD = lds + 17408; LAS unsigned char* VS = lds + 34816; LAS unsigned char* SV = lds + 52224; LAS unsigned char* PP = lds + 87040;
    LAS float* SEG = (LAS float*)(lds + 96256); LAS float* SSQ = (LAS float*)(lds + 100352);
    const size_t row0 = (size_t)b * 2048 + n * 64;
    const int kp = tid & 63, sg = wid;
    f32x2 cum[8]; unsigned qq[8], kk[8];
#pragma unroll
    for (int r = 0; r < 8; ++r) { const size_t row = row0 + sg * 8 + r;
        cum[r] = *(const f32x2*)(logf + row * 512 + h * 128 + 2 * kp);
        qq[r] = *(const unsigned*)(proj + row * NIN + h * 128 + 2 * kp); kk[r] = *(const unsigned*)(proj + row * NIN + 512 + h * 128 + 2 * kp); }
#pragma unroll
    for (int r = 1; r < 8; ++r) cum[r] += cum[r - 1];
    *(LAS f32x2*)(SEG + sg * 128 + 2 * kp) = cum[7];
    { const int s = tid >> 3, ch = tid & 7; const bf16_t* vp = proj + (row0 + s) * NIN + 1024 + h * 128 + ch * 16;
      *(LAS u32x4*)(VS + s * RS + ch * 32) = *(const u32x4*)vp; *(LAS u32x4*)(VS + s * RS + ch * 32 + 16) = *(const u32x4*)(vp + 8); }
#pragma unroll
    for (int i = 0; i < 4; ++i) { const int c = tid + 512 * i, v = c >> 4, kc = c & 15;
        *(LAS u32x4*)(SV + v * RS + kc * 16) = *(const u32x4*)(St + (size_t)item * 16384 + v * 128 + kc * 8); }
    __syncthreads();
    { f32x2 off = (f32x2){0.f, 0.f};
      for (int j = 0; j < sg; ++j) off += *(const LAS f32x2*)(SEG + j * 128 + 2 * kp);
#pragma unroll
      for (int r = 0; r < 8; ++r) { const f32x2 c = cum[r] + off; const int s = sg * 8 + r;
          *(LAS unsigned*)(QD + s * RS + 4 * kp) = pk2(bflo(qq[r]) * __expf(c.x), bfhi(qq[r]) * __expf(c.y));
          *(LAS unsigned*)(KD + s * RS + 4 * kp) = pk2(bflo(kk[r]) * __expf(-c.x), bfhi(kk[r]) * __expf(-c.y)); } }
    __syncthreads();
    const int tt = wid & 3, hh = wid >> 2;
    bf16x8 aq[4];
#pragma unroll
    for (int k4 = 0; k4 < 4; ++k4) aq[k4] = *(const LAS bf16x8*)(QD + (16 * tt + fr) * RS + (32 * k4 + 8 * fq) * 2);
#pragma unroll
    for (int si = 0; si < 2; ++si) { const int st = hh * 2 + si;
        f32x4 acc = (f32x4){0.f, 0.f, 0.f, 0.f};
        if (st <= tt) {
#pragma unroll
            for (int k4 = 0; k4 < 4; ++k4) { const bf16x8 bk = *(const LAS bf16x8*)(KD + (16 * st + fr) * RS + (32 * k4 + 8 * fq) * 2);
                acc = __builtin_amdgcn_mfma_f32_16x16x32_bf16(aq[k4], bk, acc, 0, 0, 0); }
        }
#pragma unroll
        for (int j = 0; j < 4; ++j) { const int t = 16 * tt + 4 * fq + j, s = 16 * st + fr; const float val = (t >= s) ? acc[j] : 0.f;
            *(LAS bf16_t*)(PP + t * PS + s * 2) = (bf16_t)(pk2(val, 0.f) & 0xffffu); } }
    __syncthreads();
    bf16x8 ap[2];
#pragma unroll
    for (int ss = 0; ss < 2; ++ss) ap[ss] = *(const LAS bf16x8*)(PP + (16 * tt + fr) * PS + (32 * ss + 8 * fq) * 2);
    f32x4 o[4];
#pragma unroll
    for (int i = 0; i < 4; ++i) { const int vt = hh * 4 + i;
        f32x4 acc = (f32x4){0.f, 0.f, 0.f, 0.f};
#pragma unroll
        for (int ss = 0; ss < 2; ++ss) { const bf16x8 bv = tr_frag(VS, RS, 32 * ss, 16 * vt, lane); acc = __builtin_amdgcn_mfma_f32_16x16x32_bf16(ap[ss], bv, acc, 0, 0, 0); }
#pragma unroll
        for (int k4 = 0; k4 < 4; ++k4) { const bf16x8 bs = *(const LAS bf16x8*)(SV + (16 * vt + fr) * RS + (32 * k4 + 8 * fq) * 2);
            acc = __builtin_amdgcn_mfma_f32_16x16x32_bf16(aq[k4], bs, acc, 0, 0, 0); }
        o[i] = acc; }
#pragma unroll
    for (int j = 0; j < 4; ++j) { float s = 0.f;
#pragma unroll
        for (int i = 0; i < 4; ++i) s += o[i][j] * o[i][j];
        s += __shfl_xor(s, 1); s += __shfl_xor(s, 2); s += __shfl_xor(s, 4); s += __shfl_xor(s, 8);
        if (fr == 0) SSQ[(16 * tt + 4 * fq + j) * 2 + hh] = s; }
    __syncthreads();
    const float* gon = a.in[11] + h * 128;
#pragma unroll
    for (int j = 0; j < 4; ++j) { const int t = 16 * tt + 4 * fq + j; const size_t row = row0 + t;
        const float rstd = rsqrtf((SSQ[t * 2] + SSQ[t * 2 + 1]) * (1.0f / 128.0f) + EPS);
#pragma unroll
        for (int i = 0; i < 4; ++i) { const int v = 16 * (hh * 4 + i) + fr;
            const float g = bf2f(proj[row * NIN + 1536 + h * 128 + v]);
            mix[row * D + h * 128 + v] = (bf16_t)(pk2(o[i][j] * rstd * gon[v] * silu_f(g), 0.f) & 0xffffu); } }
    __syncthreads();
}

constexpr int N_PHASES = 11;
__global__ void __launch_bounds__(512, 2) fwd_megakernel(Args args) {
    extern __shared__ __attribute__((aligned(16))) unsigned char lds_raw[];
    LAS unsigned char* lds = (LAS unsigned char*)lds_raw;
    const int lo = args.ph_lo, hi = args.ph_hi;
    unsigned char* ws = args.ws;
    float* mod = (float*)(ws + WS_MOD);
#define IN(k) (lo <= (k) && (k) < hi)
#define SYNC_AFTER(k) do { if (IN(k) && IN((k) + 1)) cg::this_grid().sync(); } while (0)
    if (IN(0)) { phase_prep(args, lds); }
    SYNC_AFTER(0);
    if (IN(1)) { phase_mod(args, lds); }
    SYNC_AFTER(1);
    if (IN(2)) { phase_norm_mod(args.in[0], args.in[1], mod, 0, 1024, (bf16_t*)(ws + WS_H)); }
    SYNC_AFTER(2);
    if (IN(3)) {
        pg8::Gemm g{(const bf16_t*)(ws + WS_H), (const bf16_t*)(ws + WS_WIN), MT, NIN, D}; pg8::StaticOrder S; S.init(MT, NIN, (int)gridDim.x, (int)blockIdx.x);
        EpiIn E{(bf16_t*)(ws + WS_PROJ), (float*)(ws + WS_LOGF), (const float*)(ws + WS_LBS)};
        pg8::gemm_phase<EpiIn, pg8::StaticOrder, true, true>(lds, g, S, E);
    }
    SYNC_AFTER(3);
    if (IN(4)) {
        for (int item = blockIdx.x; item < 256; item += gridDim.x) {
            if (item < 128) scan_item(item, args, lds);
            else { for (int i = 0; i < 4; ++i) sample_pair((item - 128) * 4 + i, args, lds); }
        }
        conv_tasks(args);
    }
    SYNC_AFTER(4);
    if (IN(5)) { for (int item = blockIdx.x; item < 1024; item += gridDim.x) passc_item(item, args, lds); }
    SYNC_AFTER(5);
    if (IN(6)) {
        pg8::Gemm g{(const bf16_t*)(ws + WS_H), (const bf16_t*)(ws + WS_WOUT), MT, D, D}; pg8::StaticOrder S; S.init(MT, D, (int)gridDim.x, (int)blockIdx.x);
        EpiRes E{args.in[0], args.in[1], args.out + O_Y, mod + 2048};
        pg8::gemm_phase<EpiRes, pg8::StaticOrder, true, true>(lds, g, S, E);
    }
    SYNC_AFTER(6);
    if (IN(7)) { phase_norm_mod(args.out + O_Y, args.out + O_Y + (size_t)NTP * D, mod, 3072, 4096, (bf16_t*)(ws + WS_H)); }
    SYNC_AFTER(7);
    if (IN(8)) {
        pg8::Gemm g{(const bf16_t*)(ws + WS_H), (const bf16_t*)(ws + WS_WUP), MT, FF, D}; pg8::StaticOrder S; S.init(MT, FF, (int)gridDim.x, (int)blockIdx.x);
        EpiUp E{(bf16_t*)(ws + WS_U)};
        pg8::gemm_phase<EpiUp, pg8::StaticOrder, true, true>(lds, g, S, E);
    }
    SYNC_AFTER(8);
    if (IN(9)) {
        pg8::Gemm g{(const bf16_t*)(ws + WS_U), (const bf16_t*)(ws + WS_WDN), MT, D, FF}; pg8::StaticOrder S; S.init(MT, D, (int)gridDim.x, (int)blockIdx.x);
        EpiRes E{args.out + O_Y, args.out + O_Y + (size_t)NTP * D, args.out + O_Y, mod + 5120};
        pg8::gemm_phase<EpiRes, pg8::StaticOrder, true, true>(lds, g, S, E);
    }
    SYNC_AFTER(9);
    if (IN(10)) { phase_final(args.out + O_Y, args.in[15]); }
#undef IN
#undef SYNC_AFTER
}

extern "C" void kernel_launch(void* const* d_in, const int* in_sizes, int n_in, void* d_out, int out_size, void* d_ws, size_t ws_size, hipStream_t stream) {
    static int grid = 0;
    if (grid == 0) {
        if (n_in != 16 || ws_size < WS_END) { fprintf(stderr, "kernel_launch: unexpected n_in %d / ws_size %zu\n", n_in, ws_size); grid = -1; return; }
        int dev = 0, cus = 0, per_cu = 0;
        hipGetDevice(&dev); hipDeviceGetAttribute(&cus, hipDeviceAttributeMultiprocessorCount, dev);
        if (hipFuncSetAttribute((const void*)fwd_megakernel, hipFuncAttributeMaxDynamicSharedMemorySize, LDS_BYTES) != hipSuccess) { fprintf(stderr, "kernel_launch: hipFuncSetAttribute failed\n"); grid = -1; return; }
        if (hipOccupancyMaxActiveBlocksPerMultiprocessor(&per_cu, (const void*)fwd_megakernel, 512, LDS_BYTES) != hipSuccess || per_cu < 1) { fprintf(stderr, "kernel_launch: occupancy query gave %d\n", per_cu); per_cu = 1; }
        (void)hipGetLastError();
        grid = cus * 1;
    }
    if (grid < 0) return;
    Args a{};
    for (int i = 0; i < 16; ++i) a.in[i] = (const float*)d_in[i];
    a.out = (float*)d_out; a.ws = (unsigned char*)d_ws;
#if ONE_LAUNCH
    a.ph_lo = 0; a.ph_hi = N_PHASES;
    void* kargs[] = {&a};
    hipError_t e = hipLaunchCooperativeKernel((const void*)fwd_megakernel, dim3(grid), dim3(512), kargs, LDS_BYTES, stream);
    if (e != hipSuccess) fprintf(stderr, "cooperative launch failed: %s (grid %d)\n", hipGetErrorString(e), grid);
#else
    for (int p = 0; p < N_PHASES; ++p) { a.ph_lo = p; a.ph_hi = p + 1; hipLaunchKernelGGL(fwd_megakernel, dim3(grid), dim3(512), LDS_BYTES, stream, a); }
#endif
}
```

```cpp
#include <hip/hip_runtime.h>
#include <hip/hip_cooperative_groups.h>
#include <cstdio>
#include <cstdint>
namespace cg = cooperative_groups;

#ifndef ONE_LAUNCH
#define ONE_LAUNCH 1
#endif
#ifndef PROBE_MASK
#define PROBE_MASK 0
#endif

#define LAS __attribute__((address_space(3)))
typedef unsigned short bf16_t;
typedef short bf16x8 __attribute__((ext_vector_type(8)));
typedef short s16x4 __attribute__((ext_vector_type(4)));
typedef float f32x4 __attribute__((ext_vector_type(4)));
typedef float f32x2 __attribute__((ext_vector_type(2)));
typedef unsigned u32x4 __attribute__((ext_vector_type(4)));
typedef unsigned u32x2 __attribute__((ext_vector_type(2)));

constexpr int D = 1024, NTP = 16384, NTS = 1024, MT = 17408, NIN = 3584, FF = 4096;
constexpr int NMOD = 6144, NMODR = 136;
constexpr float EPS = 1e-6f;
constexpr size_t O_Y = 0, O_RECP = (size_t)MT * D, O_CONVP = O_RECP + 8 * 4 * 128 * 128, O_RECS = O_CONVP + 8 * 2 * 512, O_CONVS = O_RECS + (size_t)128 * 4 * 128 * 128;
constexpr size_t WS_WIN = 0, WS_WOUT = 7340032, WS_WUP = 9437184, WS_WDN = 17825792, WS_MOD = 26214400, WS_SBF = 29556736, WS_LBS = 29851648;
constexpr size_t WS_H = 30408704, WS_PROJ = 66060288, WS_LOGF = 190840832, WS_ST = 226492416, WS_U = WS_PROJ, WS_END = 260046848;
constexpr size_t WS_CTL = 29857792; constexpr int CTL_BYTES = 65536;
constexpr int LDS_MAIN = 131072, LDS_BYTES = LDS_MAIN + 16;

__device__ __forceinline__ unsigned pk2(float lo, float hi) { unsigned r; asm("v_cvt_pk_bf16_f32 %0, %1, %2" : "=v"(r) : "v"(lo), "v"(hi)); return r; }
__device__ __forceinline__ float bflo(unsigned w) { return __uint_as_float(w << 16); }
__device__ __forceinline__ float bfhi(unsigned w) { return __uint_as_float(w & 0xffff0000u); }
__device__ __forceinline__ float bf2f(bf16_t b) { return __uint_as_float(((unsigned)b) << 16); }
__device__ __forceinline__ float wave_sum(float v) {
#pragma unroll
    for (int o = 1; o < 64; o <<= 1) v += __shfl_xor(v, o);
    return v;
}
__device__ __forceinline__ float silu_f(float x) { return x * __builtin_amdgcn_rcpf(1.0f + __expf(-x)); }

namespace pg8 {
constexpr int BM = 256, BK = 64, HALF = 128, HTB = HALF * BK * 2, STAGE_BYTES = 8 * HTB, NXCD = 8, WGM = 8;
__host__ __device__ __forceinline__ int lds_byte(int r, int c) { const int st = (r >> 4) * 2 + (c >> 5), rr = r & 15, cc = c & 31, ob = rr * 64 + cc * 2; return st * 1024 + (ob ^ (((ob >> 9) & 1) << 5)); }
__host__ __device__ __forceinline__ void stage_rc(int b, int& R, int& C) { const int st = b / 1024, sb = b % 1024, swz = sb ^ (((sb >> 9) & 1) << 5); R = (st >> 1) * 16 + swz / 64; C = (st & 1) * 32 + (swz % 64) / 2; }
__host__ __device__ __forceinline__ int perm32(int rho) { const int n = rho >> 4, i = rho & 15; return 8 * (i >> 2) + 4 * n + (i & 3); }

struct Unit { int pm, pn; };
struct Gemm { const bf16_t* A; const bf16_t* Bt; int M, N, K; };

struct StaticOrder {
    int nM, nN, nwg, G, c;
    __host__ __device__ void init(int M, int N, int G_, int c_) { nM = M / BM; nN = N / BM; nwg = nM * nN; G = G_; c = c_; }
    __host__ __device__ bool next(int i, Unit& u) const {
        const long L = (long)i * G + c; if (L >= nwg) return false;
        int wgid = (int)L; { const int q = nwg / NXCD, r = nwg % NXCD, xcd = wgid % NXCD, off = wgid / NXCD; wgid = (xcd < r ? xcd * (q + 1) : r * (q + 1) + (xcd - r) * q) + off; }
        const int nig = WGM * nN, gid = wgid / nig, fm = gid * WGM, gsz = (nM - fm) < WGM ? (nM - fm) : WGM;
        u.pm = fm + ((wgid % nig) % gsz); u.pn = (wgid % nig) / gsz; return true;
    }
    __device__ __forceinline__ void a_ready(const Unit&) const {}
    __device__ __forceinline__ void done(const Unit&) const {}
};


template <class Epi, class Sched, bool ALIGN_EPI = false, bool SP2 = false>
__device__ __forceinline__ void gemm_phase(LAS unsigned char* lds, const Gemm g, const Sched& S, const Epi& E) {
    const int tid = threadIdx.x, wid = __builtin_amdgcn_readfirstlane(tid >> 6), lane = tid & 63, wr = wid >> 2, wc = wid & 3, fr = lane & 15, fq = lane >> 4;
    const int K = g.K, nt = K / BK;
    unsigned voffA[2], voffB[2];
#pragma unroll
    for (int i = 0; i < 2; ++i) { int R, C; stage_rc(tid * 16 + i * 8192, R, C); const int Rb = Epi::PERM ? ((R & ~31) + perm32(R & 31)) : R;
        voffA[i] = (unsigned)(R * K + C) * 2u; voffB[i] = (unsigned)(Rb * K + C) * 2u; }
    const size_t kstep = (size_t)(BK * 2);
    const size_t hstep = (size_t)HALF * K * 2;
    const size_t tstep = 2 * hstep;
    const unsigned ldsw = (unsigned)wid * 1024u;
    const int aoff = lds_byte(wr * 64 + fr, fq * 8), boff = lds_byte(wc * 32 + fr, fq * 8);
#define PG8_SA(b, h) (((b) * 2 + (h)) * HTB)
#define PG8_SB(b, h) ((4 + (b) * 2 + (h)) * HTB)
#define PG8_STAGE(bufoff, gbase, voff) do { _Pragma("unroll") for (int _i = 0; _i < 2; ++_i) \
        __builtin_amdgcn_global_load_lds((const unsigned*)((const char*)(gbase) + (voff)[_i]), (LAS unsigned*)(lds + (bufoff) + ldsw + _i * 8192), 16, 0, 0); } while (0)
#define PG8_LDA(dst, b, h) do { _Pragma("unroll") for (int m = 0; m < 4; ++m) _Pragma("unroll") for (int k = 0; k < 2; ++k) dst[m][k] = *(const LAS bf16x8*)(lds + PG8_SA(b, h) + aoff + m * 2048 + k * 1024); } while (0)
#define PG8_LDB(dst, b, h) do { _Pragma("unroll") for (int n = 0; n < 2; ++n) _Pragma("unroll") for (int k = 0; k < 2; ++k) dst[n][k] = *(const LAS bf16x8*)(lds + PG8_SB(b, h) + boff + n * 2048 + k * 1024); } while (0)
#define PG8_MMA(ai, bj, At, Bt) do { __builtin_amdgcn_s_setprio(1); _Pragma("unroll") for (int m = 0; m < 4; ++m) _Pragma("unroll") for (int n = 0; n < 2; ++n) _Pragma("unroll") for (int k = 0; k < 2; ++k) \
        acc[ai][bj][m][n] = __builtin_amdgcn_mfma_f32_16x16x32_bf16(Bt[n][k], At[m][k], acc[ai][bj][m][n], 0, 0, 0); __builtin_amdgcn_s_setprio(0); } while (0)
#define PG8_WAIT_V(n) asm volatile("s_waitcnt vmcnt(" #n ")" ::: "memory")
#define PG8_WAIT_L(n) asm volatile("s_waitcnt lgkmcnt(" #n ")" ::: "memory")
#define PG8_BAR __builtin_amdgcn_s_barrier()
#define PG8_SCHED __builtin_amdgcn_sched_barrier(0)
    Unit cur, nxt; int ui = 0;
    if (!S.next(0, cur)) return;
    f32x4 acc[2][2][4][2];
#pragma unroll
    for (int a = 0; a < 2; ++a)
#pragma unroll
        for (int b = 0; b < 2; ++b)
#pragma unroll
            for (int m = 0; m < 4; ++m)
#pragma unroll
                for (int n = 0; n < 2; ++n) acc[a][b][m][n] = (f32x4){0.f, 0.f, 0.f, 0.f};
    bf16x8 At[4][2], B0[2][2], B1[2][2];
    const char* cA = (const char*)g.A + (size_t)cur.pm * tstep; const char* cB = (const char*)g.Bt + (size_t)cur.pn * tstep;
    S.a_ready(cur);
    if constexpr (SP2) {
        PG8_STAGE(PG8_SB(0, 0), cB, voffB); PG8_STAGE(PG8_SB(0, 1), cB + hstep, voffB); PG8_STAGE(PG8_SA(0, 0), cA, voffA); PG8_STAGE(PG8_SA(0, 1), cA + hstep, voffA);
        if (wr == 1) PG8_BAR;
        PG8_WAIT_V(2); PG8_BAR;
        PG8_STAGE(PG8_SB(1, 0), cB + kstep, voffB); PG8_STAGE(PG8_SA(1, 0), cA + kstep, voffA); PG8_STAGE(PG8_SB(1, 1), cB + hstep + kstep, voffB);
        PG8_WAIT_V(6); PG8_BAR;
    } else {
        PG8_STAGE(PG8_SB(0, 0), cB, voffB); PG8_STAGE(PG8_SA(0, 0), cA, voffA); PG8_STAGE(PG8_SB(0, 1), cB + hstep, voffB); PG8_STAGE(PG8_SA(0, 1), cA + hstep, voffA);
        if (wr == 1) PG8_BAR;
        PG8_WAIT_V(4); PG8_BAR;
        PG8_STAGE(PG8_SB(1, 0), cB + kstep, voffB); PG8_STAGE(PG8_SA(1, 0), cA + kstep, voffA); PG8_STAGE(PG8_SB(1, 1), cB + hstep + kstep, voffB);
        PG8_WAIT_V(6); PG8_BAR;
    }
    for (;;) {
        const bool has_next = S.next(ui + 1, nxt);
        const char* nA = has_next ? (const char*)g.A + (size_t)nxt.pm * tstep : cA; const char* nB = has_next ? (const char*)g.Bt + (size_t)nxt.pn * tstep : cB;
        for (int t = 0; t < nt; t += 2) {
            const bool last = (t == nt - 2);
            const char* a1 = cA + (size_t)(t + 1) * kstep;
            const char* a2 = last ? nA : cA + (size_t)(t + 2) * kstep; const char* b2 = last ? nB : cB + (size_t)(t + 2) * kstep;
            const char* a3 = a2 + kstep; const char* b3 = b2 + kstep;
            if (last && has_next) S.a_ready(nxt);
            if constexpr (SP2) {
            PG8_LDB(B0, 0, 0); PG8_LDB(B1, 0, 1); PG8_SCHED; PG8_LDA(At, 0, 0); PG8_STAGE(PG8_SA(1, 1), a1 + hstep, voffA);
            PG8_WAIT_V(8); PG8_WAIT_L(0); PG8_BAR; PG8_MMA(0, 0, At, B0); PG8_MMA(0, 1, At, B1); PG8_BAR; PG8_SCHED;
            PG8_LDA(At, 0, 1); PG8_STAGE(PG8_SB(0, 0), b2, voffB); PG8_STAGE(PG8_SB(0, 1), b2 + hstep, voffB); PG8_STAGE(PG8_SA(0, 0), a2, voffA);
            PG8_WAIT_V(8); PG8_WAIT_L(0); PG8_BAR; PG8_MMA(1, 0, At, B0); PG8_MMA(1, 1, At, B1); PG8_BAR; PG8_SCHED;
            PG8_LDB(B0, 1, 0); PG8_LDB(B1, 1, 1); PG8_SCHED; PG8_LDA(At, 1, 0); PG8_STAGE(PG8_SA(0, 1), a2 + hstep, voffA);
            PG8_WAIT_V(8); PG8_WAIT_L(0); PG8_BAR; PG8_MMA(0, 0, At, B0); PG8_MMA(0, 1, At, B1); PG8_BAR; PG8_SCHED;
            PG8_LDA(At, 1, 1); PG8_STAGE(PG8_SB(1, 0), b3, voffB); PG8_STAGE(PG8_SB(1, 1), b3 + hstep, voffB); PG8_STAGE(PG8_SA(1, 0), a3, voffA);
            PG8_WAIT_V(8); PG8_WAIT_L(0); PG8_BAR; PG8_MMA(1, 0, At, B0); PG8_MMA(1, 1, At, B1); PG8_BAR; PG8_SCHED;
            } else {
            PG8_LDB(B0, 0, 0); PG8_SCHED; PG8_LDA(At, 0, 0); PG8_STAGE(PG8_SA(1, 1), a1 + hstep, voffA);
            PG8_WAIT_L(8); PG8_BAR; PG8_WAIT_L(0); PG8_MMA(0, 0, At, B0); PG8_BAR; PG8_SCHED;
            PG8_LDB(B1, 0, 1); PG8_STAGE(PG8_SB(0, 0), b2, voffB);
            PG8_BAR; PG8_WAIT_L(0); PG8_MMA(0, 1, At, B1); PG8_BAR;
            PG8_LDA(At, 0, 1); PG8_STAGE(PG8_SA(0, 0), a2, voffA);
            PG8_BAR; PG8_WAIT_L(0); PG8_MMA(1, 0, At, B0); PG8_BAR; PG8_SCHED;
            PG8_STAGE(PG8_SB(0, 1), b2 + hstep, voffB);
            PG8_WAIT_V(6); PG8_BAR; PG8_MMA(1, 1, At, B1); PG8_BAR;
            PG8_LDB(B0, 1, 0); PG8_SCHED; PG8_LDA(At, 1, 0); PG8_STAGE(PG8_SA(0, 1), a2 + hstep, voffA);
            PG8_WAIT_L(8); PG8_BAR; PG8_WAIT_L(0); PG8_MMA(0, 0, At, B0); PG8_BAR; PG8_SCHED;
            PG8_LDB(B1, 1, 1); PG8_STAGE(PG8_SB(1, 0), b3, voffB);
            PG8_BAR; PG8_WAIT_L(0); PG8_MMA(0, 1, At, B1); PG8_BAR;
            PG8_LDA(At, 1, 1); PG8_STAGE(PG8_SA(1, 0), a3, voffA);
            PG8_BAR; PG8_WAIT_L(0); PG8_MMA(1, 0, At, B0); PG8_BAR; PG8_SCHED;
            PG8_STAGE(PG8_SB(1, 1), b3 + hstep, voffB);
            PG8_WAIT_V(6); PG8_BAR; PG8_MMA(1, 1, At, B1); PG8_BAR;
            }
        }
        if constexpr (ALIGN_EPI) { if (wr == 0) PG8_BAR; }
        E(acc, cur, wr, wc, fr, fq); S.done(cur);
        if (!has_next) break;
#pragma unroll
        for (int a = 0; a < 2; ++a)
#pragma unroll
            for (int b = 0; b < 2; ++b)
#pragma unroll
                for (int m = 0; m < 4; ++m)
#pragma unroll
                    for (int n = 0; n < 2; ++n) acc[a][b][m][n] = (f32x4){0.f, 0.f, 0.f, 0.f};
        cur = nxt; cA = nA; cB = nB; ++ui;
        if constexpr (ALIGN_EPI) { if (wr == 1) PG8_BAR; }
    }
    PG8_WAIT_V(0);
    if constexpr (!ALIGN_EPI) { if (wr == 0) PG8_BAR; }
    PG8_BAR;
#undef PG8_SA
#undef PG8_SB
#undef PG8_STAGE
#undef PG8_LDA
#undef PG8_LDB
#undef PG8_MMA
#undef PG8_WAIT_V
#undef PG8_WAIT_L
#undef PG8_BAR
#undef PG8_SCHED
}
}

struct EpiIn {
    static constexpr bool PERM = true;
    bf16_t* proj; float* logf; const float* lbs;
    __device__ __forceinline__ void operator()(const f32x4 (&acc)[2][2][4][2], const pg8::Unit& u, int wr, int wc, int fr, int fq) const {
        const int row0 = u.pm * 256 + wr * 64 + fr, colt = u.pn * 256 + wc * 32 + 8 * fq;
        const bool isf = (u.pn >> 1) == 1;
        if (!isf) {
#pragma unroll
            for (int ai = 0; ai < 2; ++ai)
#pragma unroll
                for (int m = 0; m < 4; ++m) { bf16_t* rowp = proj + (size_t)(row0 + ai * 128 + m * 16) * NIN + colt;
#pragma unroll
                    for (int bj = 0; bj < 2; ++bj) { const f32x4 v0 = acc[ai][bj][m][0], v1 = acc[ai][bj][m][1];
                        u32x4 w; w.x = pk2(v0[0], v0[1]); w.y = pk2(v0[2], v0[3]); w.z = pk2(v1[0], v1[1]); w.w = pk2(v1[2], v1[3]);
                        *(u32x4*)(rowp + bj * 128) = w; } }
        } else {
#pragma unroll
            for (int bj = 0; bj < 2; ++bj) {
                const int col = colt + bj * 128 - 512;
                const f32x4 lb0 = *(const f32x4*)(lbs + col), lb1 = *(const f32x4*)(lbs + col + 4);
#pragma unroll
                for (int ai = 0; ai < 2; ++ai)
#pragma unroll
                    for (int m = 0; m < 4; ++m) { const size_t row = (size_t)(row0 + ai * 128 + m * 16);
                        f32x4 lg[2], kk[2];
#pragma unroll
                        for (int n = 0; n < 2; ++n)
#pragma unroll
                            for (int j = 0; j < 4; ++j) { const float lb = n ? lb1[j] : lb0[j]; float fz = acc[ai][bj][m][n][j]; fz = fminf(fmaxf(fz, -30.f), 30.f);
                                const float e = __expf(-fz), sg = __builtin_amdgcn_rcpf(1.0f + e);
                                lg[n][j] = __logf(lb + (1.0f - lb) * sg); kk[n][j] = (1.0f - lb) * e * sg; }
                        *(f32x4*)(logf + row * 512 + col) = lg[0]; *(f32x4*)(logf + row * 512 + col + 4) = lg[1];
                        u32x4 w; w.x = pk2(kk[0][0], kk[0][1]); w.y = pk2(kk[0][2], kk[0][3]); w.z = pk2(kk[1][0], kk[1][1]); w.w = pk2(kk[1][2], kk[1][3]);
                        *(u32x4*)(proj + row * NIN + colt + bj * 128) = w; }
            }
        }
    }
};
struct EpiRes {
    static constexpr bool PERM = false;
    const float* basep; const float* bases; float* out; const float* gate;
    __device__ __forceinline__ void operator()(const f32x4 (&acc)[2][2][4][2], const pg8::Unit& u, int wr, int wc, int fr, int fq) const {
        const int row0 = u.pm * 256 + wr * 64 + fr, col0 = u.pn * 256 + wc * 32 + 4 * fq;
#pragma unroll
        for (int ai = 0; ai < 2; ++ai)
#pragma unroll
            for (int m = 0; m < 4; ++m) { const int row = row0 + ai * 128 + m * 16;
                const float* bp = row < NTP ? basep + (size_t)row * D : bases + (size_t)(row - NTP) * D;
                const int mb = row < NTP ? (row >> 11) : 8 + ((row - NTP) >> 3);
                const float* gp = gate + (size_t)mb * NMOD + col0; float* op = out + (size_t)row * D + col0;
#pragma unroll
                for (int bj = 0; bj < 2; ++bj)
#pragma unroll
                    for (int n = 0; n < 2; ++n) { const int c = bj * 128 + n * 16;
                        const f32x4 bs = *(const f32x4*)(bp + col0 + c), gv = *(const f32x4*)(gp + c);
                        *(f32x4*)(op + c) = bs + gv * acc[ai][bj][m][n]; }
                asm volatile("" ::: "memory"); }
    }
};
struct EpiUp {
    static constexpr bool PERM = true;
    bf16_t* U;
    __device__ __forceinline__ void operator()(const f32x4 (&acc)[2][2][4][2], const pg8::Unit& u, int wr, int wc, int fr, int fq) const {
        const int row0 = u.pm * 256 + wr * 64 + fr, colt = u.pn * 256 + wc * 32 + 8 * fq;
#pragma unroll
        for (int ai = 0; ai < 2; ++ai)
#pragma unroll
            for (int m = 0; m < 4; ++m) { bf16_t* rowp = U + (size_t)(row0 + ai * 128 + m * 16) * FF + colt;
#pragma unroll
                for (int bj = 0; bj < 2; ++bj) { f32x4 v0 = acc[ai][bj][m][0], v1 = acc[ai][bj][m][1];
#pragma unroll
                    for (int j = 0; j < 4; ++j) { const float a = fmaxf(v0[j], 0.f), b = fmaxf(v1[j], 0.f); v0[j] = a * a; v1[j] = b * b; }
                    u32x4 w; w.x = pk2(v0[0], v0[1]); w.y = pk2(v0[2], v0[3]); w.z = pk2(v1[0], v1[1]); w.w = pk2(v1[2], v1[3]);
                    *(u32x4*)(rowp + bj * 128) = w; } }
    }
};

struct Args { const float* in[16]; float* out; unsigned char* ws; int ph_lo, ph_hi; };

__device__ __forceinline__ void p0_transpose_item(const float* __restrict__ W, int K, int N, bf16_t* __restrict__ WT, LAS float* scr, int item, int lane) {
    const int nblk = N / 32, kb = item / nblk, nb = item % nblk, k0 = 64 * kb, n0 = 32 * nb;
#pragma unroll
    for (int i = 0; i < 32; ++i) { const int kk = 2 * i + (lane >> 5); scr[kk * 33 + (lane & 31)] = W[(size_t)(k0 + kk) * N + n0 + (lane & 31)]; }
    asm volatile("s_waitcnt lgkmcnt(0)" ::: "memory");
    const int c = lane & 7;
#pragma unroll
    for (int j = 0; j < 4; ++j) { const int n = (lane >> 3) + 8 * j; const LAS float* s = scr + (8 * c) * 33 + n;
        u32x4 o; o.x = pk2(s[0 * 33], s[1 * 33]); o.y = pk2(s[2 * 33], s[3 * 33]); o.z = pk2(s[4 * 33], s[5 * 33]); o.w = pk2(s[6 * 33], s[7 * 33]);
        *(u32x4*)(WT + (size_t)(n0 + n) * K + k0 + 8 * c) = o; }
    asm volatile("s_waitcnt lgkmcnt(0)" ::: "memory");
}

__device__ __forceinline__ void phase_prep(const Args& a, LAS unsigned char* lds) {
    const int tid = threadIdx.x, lane = tid & 63, wid = __builtin_amdgcn_readfirstlane(tid >> 6);
    LAS float* scr = (LAS float*)(lds + wid * 16384);
    const int gw = blockIdx.x * 8 + wid, NGW = gridDim.x * 8;
    constexpr int I_IN = 16 * 112, I_OUT = 16 * 32, I_UP = 16 * 128, I_DN = 64 * 32, NITEMS = I_IN + I_OUT + I_UP + I_DN;
    for (int it = gw; it < NITEMS; it += NGW) {
        int r = it;
        if (r < I_IN) { p0_transpose_item(a.in[9], D, NIN, (bf16_t*)(a.ws + WS_WIN), scr, r, lane); continue; } r -= I_IN;
        if (r < I_OUT) { p0_transpose_item(a.in[12], D, D, (bf16_t*)(a.ws + WS_WOUT), scr, r, lane); continue; } r -= I_OUT;
        if (r < I_UP) { p0_transpose_item(a.in[13], D, FF, (bf16_t*)(a.ws + WS_WUP), scr, r, lane); continue; } r -= I_UP;
        p0_transpose_item(a.in[14], FF, D, (bf16_t*)(a.ws + WS_WDN), scr, r, lane);
    }
    bf16_t* sbf = (bf16_t*)(a.ws + WS_SBF);
    for (int i = blockIdx.x * 512 + tid; i < NMODR * D / 2; i += gridDim.x * 512) {
        const int e = 2 * i; const float* src = e < 8 * D ? a.in[4] + e : a.in[5] + (e - 8 * D);
        const f32x2 v = *(const f32x2*)src; *(unsigned*)(sbf + e) = pk2(silu_f(v.x), silu_f(v.y));
    }
    float* lbs = (float*)(a.ws + WS_LBS);
    for (int i = blockIdx.x * 512 + tid; i < 512; i += gridDim.x * 512) { const float x0 = a.in[6][i], x1 = a.in[6][512 + i]; lbs[i] = 1.0f / (1.0f + __expf(x1 - x0)); }
}

__device__ __forceinline__ void phase_mod(const Args& a, LAS unsigned char* lds) {
    const int tid = threadIdx.x, lane = tid & 63, wid = __builtin_amdgcn_readfirstlane(tid >> 6), fr = lane & 15, fq = lane >> 4;
    const float* __restrict__ w_ada = a.in[7]; const float* __restrict__ b_ada = a.in[8];
    const bf16_t* sbf = (const bf16_t*)(a.ws + WS_SBF); float* mod = (float*)(a.ws + WS_MOD);
    LAS float* red = (LAS float*)lds;
    for (int item = blockIdx.x; item < 192; item += gridDim.x) {
        const int ntile = item * 2 + (wid >> 2), ks = wid & 3, n0 = ntile * 16, kb = ks * 256;
        f32x4 acc[9];
#pragma unroll
        for (int mt = 0; mt < 9; ++mt) acc[mt] = (f32x4){0.f, 0.f, 0.f, 0.f};
        float wv[8][8];
#pragma unroll
        for (int kk = 0; kk < 8; ++kk)
#pragma unroll
            for (int e = 0; e < 8; ++e) wv[kk][e] = w_ada[(size_t)(kb + kk * 32 + fq * 8 + e) * NMOD + n0 + fr];
#pragma unroll
        for (int kk = 0; kk < 8; ++kk) {
            const int k0 = kb + kk * 32 + fq * 8;
            u32x4 bw; bw.x = pk2(wv[kk][0], wv[kk][1]); bw.y = pk2(wv[kk][2], wv[kk][3]); bw.z = pk2(wv[kk][4], wv[kk][5]); bw.w = pk2(wv[kk][6], wv[kk][7]);
            const bf16x8 bfrag = __builtin_bit_cast(bf16x8, bw);
#pragma unroll
            for (int mt = 0; mt < 9; ++mt) { int row = mt * 16 + fr; row = row > 135 ? 135 : row;
                const bf16x8 afrag = *(const bf16x8*)(sbf + (size_t)row * D + k0);
                acc[mt] = __builtin_amdgcn_mfma_f32_16x16x32_bf16(afrag, bfrag, acc[mt], 0, 0, 0); }
        }
#pragma unroll
        for (int mt = 0; mt < 9; ++mt)
#pragma unroll
            for (int j = 0; j < 4; ++j) red[(wid * 36 + mt * 4 + j) * 64 + lane] = acc[mt][j];
        __syncthreads();
        for (int o = tid; o < 4608; o += 512) {
            const int t = o / 2304, rem = o % 2304, row = rem >> 4, col = rem & 15, mt = row >> 4, r = row & 15, q = r >> 2, j = r & 3, ln = q * 16 + col;
            float s = 0.f;
#pragma unroll
            for (int k2 = 0; k2 < 4; ++k2) s += red[((t * 4 + k2) * 36 + mt * 4 + j) * 64 + ln];
            const int n = (item * 2 + t) * 16 + col;
            if (row < NMODR) mod[(size_t)row * NMOD + n] = s + b_ada[n];
        }
        __syncthreads();
    }
}

__device__ __forceinline__ void phase_norm_mod(const float* src0, const float* src1, const float* mod, int sh_off, int sc_off, bf16_t* out) {
    const int tid = threadIdx.x, lane = tid & 63, wid = __builtin_amdgcn_readfirstlane(tid >> 6);
    const int gw = blockIdx.x * 8 + wid, NGW = gridDim.x * 8;
    int row = gw;
    f32x4 v[4];
    if (row < MT) { const float* xr = row < NTP ? src0 + (size_t)row * D : src1 + (size_t)(row - NTP) * D;
#pragma unroll
        for (int j = 0; j < 4; ++j) v[j] = *(const f32x4*)(xr + 4 * lane + 256 * j); }
    while (row < MT) {
        const int nrow = row + NGW;
        const int mb = row < NTP ? (row >> 11) : 8 + ((row - NTP) >> 3);
        const float* mr = mod + (size_t)mb * NMOD;
        f32x4 sc[4], sh[4], vn[4];
#pragma unroll
        for (int j = 0; j < 4; ++j) { sc[j] = *(const f32x4*)(mr + sc_off + 4 * lane + 256 * j); sh[j] = *(const f32x4*)(mr + sh_off + 4 * lane + 256 * j); }
        if (nrow < MT) { const float* xr = nrow < NTP ? src0 + (size_t)nrow * D : src1 + (size_t)(nrow - NTP) * D;
#pragma unroll
            for (int j = 0; j < 4; ++j) vn[j] = *(const f32x4*)(xr + 4 * lane + 256 * j); }
        float s = 0.f;
#pragma unroll
        for (int j = 0; j < 4; ++j) s += (v[j].x * v[j].x + v[j].y * v[j].y) + (v[j].z * v[j].z + v[j].w * v[j].w);
        const float rstd = rsqrtf(wave_sum(s) * (1.0f / D) + EPS);
#pragma unroll
        for (int j = 0; j < 4; ++j) { const f32x4 o = v[j] * rstd * (sc[j] + 1.0f) + sh[j]; u32x2 w; w.x = pk2(o.x, o.y); w.y = pk2(o.z, o.w);
            *(u32x2*)(out + (size_t)row * D + 4 * lane + 256 * j) = w; }
#pragma unroll
        for (int j = 0; j < 4; ++j) v[j] = vn[j];
        row = nrow;
    }
}

__device__ __forceinline__ void phase_final(float* y, const float* gfin) {
    const int tid = threadIdx.x, lane = tid & 63, wid = __builtin_amdgcn_readfirstlane(tid >> 6);
    const int gw = blockIdx.x * 8 + wid, NGW = gridDim.x * 8;
    f32x4 gf[4];
#pragma unroll
    for (int j = 0; j < 4; ++j) gf[j] = *(const f32x4*)(gfin + 4 * lane + 256 * j);
    for (int row = gw; row < MT; row += NGW) {
        float* xr = y + (size_t)row * D;
        f32x4 v[4]; float s = 0.f;
#pragma unroll
        for (int j = 0; j < 4; ++j) { v[j] = *(const f32x4*)(xr + 4 * lane + 256 * j); s += (v[j].x * v[j].x + v[j].y * v[j].y) + (v[j].z * v[j].z + v[j].w * v[j].w); }
        const float rstd = rsqrtf(wave_sum(s) * (1.0f / D) + EPS);
#pragma unroll
        for (int j = 0; j < 4; ++j) *(f32x4*)(xr + 4 * lane + 256 * j) = v[j] * rstd * gf[j];
    }
}

__device__ __forceinline__ bf16x8 tr_frag(LAS unsigned char* base, int stride_bytes, int r0, int c0, int lane) {
    const int g = lane >> 4, q = (lane >> 2) & 3, p = lane & 3;
    LAS unsigned char* a0 = base + (r0 + 8 * g + q) * stride_bytes + (c0 + 4 * p) * 2;
    const s16x4 lo = __builtin_amdgcn_ds_read_tr16_b64_v4i16((LAS s16x4*)a0);
    const s16x4 hi = __builtin_amdgcn_ds_read_tr16_b64_v4i16((LAS s16x4*)(a0 + 4 * stride_bytes));
    bf16x8 r; r[0] = lo[0]; r[1] = lo[1]; r[2] = lo[2]; r[3] = lo[3]; r[4] = hi[0]; r[5] = hi[1]; r[6] = hi[2]; r[7] = hi[3]; return r;
}

struct ScanRegs { f32x4 lf; u32x2 kw; u32x4 v0, v1; };
__device__ __forceinline__ void scan_load(ScanRegs& r, const float* lfp, const bf16_t* kp, const bf16_t* vp, int n) {
    r.lf = *(const f32x4*)(lfp + (size_t)n * 64 * 512); r.kw = *(const u32x2*)(kp + (size_t)n * 64 * NIN);
    r.v0 = *(const u32x4*)(vp + (size_t)n * 64 * NIN); r.v1 = *(const u32x4*)(vp + (size_t)n * 64 * NIN + 8);
}
__device__ __forceinline__ void scan_item(int item, const Args& a, LAS unsigned char* lds) {
    const int tid = threadIdx.x, lane = tid & 63, wid = __builtin_amdgcn_readfirstlane(tid >> 6), fr = lane & 15, fq = lane >> 4;
    const int b = item >> 4, h = (item >> 2) & 3, ks = item & 3;
    const bf16_t* proj = (const bf16_t*)(a.ws + WS_PROJ); const float* logf = (const float*)(a.ws + WS_LOGF); bf16_t* St = (bf16_t*)(a.ws + WS_ST);
    constexpr int KE_STR = 72, VS_STR = 272, KE_BYTES = 64 * KE_STR, VS_BYTES = 64 * VS_STR;
    LAS unsigned char* KE = lds; LAS unsigned char* VS = lds + 2 * KE_BYTES; LAS float* DEC = (LAS float*)(lds + 2 * KE_BYTES + 2 * VS_BYTES);
    const int vs_s = tid >> 3, vs_ch = tid & 7;
    const size_t rowb = (size_t)b * 2048;
    const float* lfp = logf + (rowb + lane) * 512 + h * 128 + ks * 32 + 4 * wid;
    const bf16_t* kp = proj + (rowb + lane) * NIN + 512 + h * 128 + ks * 32 + 4 * wid;
    const bf16_t* vp = proj + (rowb + vs_s) * NIN + 1024 + h * 128 + vs_ch * 16;
    f32x4 S[2]; S[0] = (f32x4){0.f, 0.f, 0.f, 0.f}; S[1] = S[0];
    ScanRegs R0, R1, R2, R3;
    scan_load(R0, lfp, kp, vp, 0); scan_load(R1, lfp, kp, vp, 1); scan_load(R2, lfp, kp, vp, 2); scan_load(R3, lfp, kp, vp, 3);
#define SCAN_STEP(R, n_) do { const int n = (n_); const int buf = n & 1; \
        f32x4 c = R.lf; \
        _Pragma("unroll") for (int d = 1; d < 64; d <<= 1) { f32x4 t; t.x = __shfl_up(c.x, d); t.y = __shfl_up(c.y, d); t.z = __shfl_up(c.z, d); t.w = __shfl_up(c.w, d); if (lane >= d) c += t; } \
        f32x4 last; last.x = __shfl(c.x, 63); last.y = __shfl(c.y, 63); last.z = __shfl(c.z, 63); last.w = __shfl(c.w, 63); \
        { const float k0 = bflo(R.kw.x), k1 = bfhi(R.kw.x), k2 = bflo(R.kw.y), k3 = bfhi(R.kw.y); \
          u32x2 w; w.x = pk2(k0 * __expf(last.x - c.x), k1 * __expf(last.y - c.y)); w.y = pk2(k2 * __expf(last.z - c.z), k3 * __expf(last.w - c.w)); \
          *(LAS u32x2*)(KE + buf * KE_BYTES + lane * KE_STR + wid * 8) = w; } \
        if (lane == 63) { f32x4 dv; dv.x = __expf(last.x); dv.y = __expf(last.y); dv.z = __expf(last.z); dv.w = __expf(last.w); *(LAS f32x4*)(DEC + buf * 32 + 4 * wid) = dv; } \
        *(LAS u32x4*)(VS + buf * VS_BYTES + vs_s * VS_STR + vs_ch * 32) = R.v0; *(LAS u32x4*)(VS + buf * VS_BYTES + vs_s * VS_STR + vs_ch * 32 + 16) = R.v1; \
        if (n + 4 < 32) scan_load(R, lfp, kp, vp, n + 4); \
        __syncthreads(); \
        { bf16_t* sp = St + ((size_t)((b * 32 + n) * 4 + h)) * 16384 + (size_t)(16 * wid + fr) * 128 + ks * 32 + 4 * fq; \
          _Pragma("unroll") for (int kt = 0; kt < 2; ++kt) { u32x2 w; w.x = pk2(S[kt][0], S[kt][1]); w.y = pk2(S[kt][2], S[kt][3]); *(u32x2*)(sp + kt * 16) = w; } } \
        _Pragma("unroll") for (int kt = 0; kt < 2; ++kt) { const f32x4 dv = *(const LAS f32x4*)(DEC + buf * 32 + kt * 16 + 4 * fq); S[kt] *= dv; } \
        _Pragma("unroll") for (int ss = 0; ss < 2; ++ss) { \
            const bf16x8 bfrag = tr_frag(VS + buf * VS_BYTES, VS_STR, 32 * ss, 16 * wid, lane); \
            _Pragma("unroll") for (int kt = 0; kt < 2; ++kt) { const bf16x8 afrag = tr_frag(KE + buf * KE_BYTES, KE_STR, 32 * ss, 16 * kt, lane); \
                S[kt] = __builtin_amdgcn_mfma_f32_16x16x32_bf16(afrag, bfrag, S[kt], 0, 0, 0); } } \
    } while (0)
#pragma unroll 1
    for (int n4 = 0; n4 < 32; n4 += 4) { SCAN_STEP(R0, n4); SCAN_STEP(R1, n4 + 1); SCAN_STEP(R2, n4 + 2); SCAN_STEP(R3, n4 + 3); }
#undef SCAN_STEP
    float* recp = a.out + O_RECP;
#pragma unroll
    for (int kt = 0; kt < 2; ++kt)
#pragma unroll
        for (int j = 0; j < 4; ++j) recp[((size_t)((b * 4 + h) * 128 + ks * 32 + kt * 16 + 4 * fq + j)) * 128 + 16 * wid + fr] = S[kt][j];
    __syncthreads();
}

__device__ __forceinline__ void sample_pair(int pair, const Args& a, LAS unsigned char* lds) {
    const int tid = threadIdx.x, lane = tid & 63, wid = __builtin_amdgcn_readfirstlane(tid >> 6);
    const int b = pair >> 2, h = pair & 3, v = tid & 127, kg = tid >> 7;
    const bf16_t* proj = (const bf16_t*)(a.ws + WS_PROJ); const float* logf = (const float*)(a.ws + WS_LOGF); bf16_t* mix = (bf16_t*)(a.ws + WS_H);
    LAS float* fT = (LAS float*)lds; LAS float* kT = fT + 1024; LAS float* qT = kT + 1024; LAS float* part = qT + 1024;
    const size_t row0 = (size_t)NTP + b * 8;
#pragma unroll
    for (int i = 0; i < 2; ++i) { const int idx = tid + 512 * i, t = idx >> 7, kk = idx & 127; const size_t row = row0 + t;
        fT[idx] = __expf(logf[row * 512 + h * 128 + kk]); kT[idx] = bf2f(proj[row * NIN + 512 + h * 128 + kk]); qT[idx] = bf2f(proj[row * NIN + h * 128 + kk]); }
    const float* s0 = a.in[2] + ((size_t)((b * 4 + h) * 128 + kg * 32)) * 128 + v;
    float S[32];
#pragma unroll
    for (int j = 0; j < 32; ++j) S[j] = s0[(size_t)j * 128];
    __syncthreads();
#pragma unroll 1
    for (int t = 0; t < 8; ++t) {
        const float vt = bf2f(proj[(row0 + t) * NIN + 1024 + h * 128 + v]);
        float op = 0.f;
#pragma unroll
        for (int j4 = 0; j4 < 8; ++j4) {
            const f32x4 f4 = *(const LAS f32x4*)(fT + t * 128 + kg * 32 + 4 * j4), k4 = *(const LAS f32x4*)(kT + t * 128 + kg * 32 + 4 * j4), q4 = *(const LAS f32x4*)(qT + t * 128 + kg * 32 + 4 * j4);
#pragma unroll
            for (int e = 0; e < 4; ++e) { S[4 * j4 + e] = f4[e] * S[4 * j4 + e] + k4[e] * vt; op += q4[e] * S[4 * j4 + e]; }
        }
        part[(t * 4 + kg) * 128 + v] = op;
    }
    float* s1 = a.out + O_RECS + ((size_t)((b * 4 + h) * 128 + kg * 32)) * 128 + v;
#pragma unroll
    for (int j = 0; j < 32; ++j) s1[(size_t)j * 128] = S[j];
    __syncthreads();
    { const int t = wid; const size_t row = row0 + t;
      float o0 = 0.f, o1 = 0.f;
#pragma unroll
      for (int g = 0; g < 4; ++g) { o0 += part[(t * 4 + g) * 128 + lane]; o1 += part[(t * 4 + g) * 128 + lane + 64]; }
      const float rstd = rsqrtf(wave_sum(o0 * o0 + o1 * o1) * (1.0f / 128.0f) + EPS);
      const float g0 = bf2f(proj[row * NIN + 1536 + h * 128 + lane]), g1 = bf2f(proj[row * NIN + 1536 + h * 128 + lane + 64]);
      const float* gon = a.in[11] + h * 128;
      const unsigned w0 = pk2(o0 * rstd * gon[lane] * silu_f(g0), 0.f), w1 = pk2(o1 * rstd * gon[lane + 64] * silu_f(g1), 0.f);
      mix[row * D + h * 128 + lane] = (bf16_t)(w0 & 0xffffu); mix[row * D + h * 128 + lane + 64] = (bf16_t)(w1 & 0xffffu); }
    __syncthreads();
}

__device__ __forceinline__ void conv_tasks(const Args& a) {
    const int tid = threadIdx.x;
    const bf16_t* proj = (const bf16_t*)(a.ws + WS_PROJ); bf16_t* mix = (bf16_t*)(a.ws + WS_H);
    const float* wconv = a.in[10];
    for (int tt = blockIdx.x * 512 + tid; tt < 2176 * 64; tt += gridDim.x * 512) {
        const int seg = tt >> 6, cgp = tt & 63, c0 = cgp * 8;
        const bool samp = seg >= 2048;
        size_t row0; int pos;
        if (!samp) { row0 = (size_t)seg * 8; pos = (seg * 8) & 2047; } else { row0 = (size_t)NTP + (size_t)(seg - 2048) * 8; pos = 0; }
        float um2[8], um1[8], w0[8], w1[8], w2[8];
        { const f32x4 a0 = *(const f32x4*)(wconv + c0), a1 = *(const f32x4*)(wconv + c0 + 4), b0 = *(const f32x4*)(wconv + 512 + c0), b1 = *(const f32x4*)(wconv + 512 + c0 + 4),
                      d0 = *(const f32x4*)(wconv + 1024 + c0), d1 = *(const f32x4*)(wconv + 1024 + c0 + 4);
#pragma unroll
          for (int e = 0; e < 4; ++e) { w0[e] = a0[e]; w0[4 + e] = a1[e]; w1[e] = b0[e]; w1[4 + e] = b1[e]; w2[e] = d0[e]; w2[4 + e] = d1[e]; } }
        if (samp) { const float* sc = a.in[3] + (size_t)(seg - 2048) * 1024 + c0;
            const f32x4 p0 = *(const f32x4*)sc, p1 = *(const f32x4*)(sc + 4), q0 = *(const f32x4*)(sc + 512), q1 = *(const f32x4*)(sc + 516);
#pragma unroll
            for (int e = 0; e < 4; ++e) { um2[e] = p0[e]; um2[4 + e] = p1[e]; um1[e] = q0[e]; um1[4 + e] = q1[e]; }
        } else if (pos >= 2) {
            const bf16_t* pr = proj + (row0 - 2) * NIN;
            const u32x4 c2 = *(const u32x4*)(pr + 2560 + c0), h2 = *(const u32x4*)(pr + 3072 + c0), c1 = *(const u32x4*)(pr + NIN + 2560 + c0), h1 = *(const u32x4*)(pr + NIN + 3072 + c0);
#pragma unroll
            for (int e = 0; e < 4; ++e) { um2[2 * e] = bflo(c2[e]) * bflo(h2[e]); um2[2 * e + 1] = bfhi(c2[e]) * bfhi(h2[e]); um1[2 * e] = bflo(c1[e]) * bflo(h1[e]); um1[2 * e + 1] = bfhi(c1[e]) * bfhi(h1[e]); }
        } else {
#pragma unroll
            for (int e = 0; e < 8; ++e) { um2[e] = 0.f; um1[e] = 0.f; }
        }
#pragma unroll
        for (int i = 0; i < 8; ++i) {
            const bf16_t* pr = proj + (row0 + i) * NIN;
            const u32x4 bv = *(const u32x4*)(pr + 2048 + c0), cv = *(const u32x4*)(pr + 2560 + c0), hv = *(const u32x4*)(pr + 3072 + c0);
            float u[8], o[8];
#pragma unroll
            for (int e = 0; e < 4; ++e) { u[2 * e] = bflo(cv[e]) * bflo(hv[e]); u[2 * e + 1] = bfhi(cv[e]) * bfhi(hv[e]); }
#pragma unroll
            for (int e = 0; e < 4; ++e) { o[2 * e] = bflo(bv[e]) * (w0[2 * e] * um2[2 * e] + w1[2 * e] * um1[2 * e] + w2[2 * e] * u[2 * e]);
                                          o[2 * e + 1] = bfhi(bv[e]) * (w0[2 * e + 1] * um2[2 * e + 1] + w1[2 * e + 1] * um1[2 * e + 1] + w2[2 * e + 1] * u[2 * e + 1]); }
            u32x4 w; w.x = pk2(o[0], o[1]); w.y = pk2(o[2], o[3]); w.z = pk2(o[4], o[5]); w.w = pk2(o[6], o[7]);
            *(u32x4*)(mix + (row0 + i) * D + 512 + c0) = w;
#pragma unroll
            for (int e = 0; e < 8; ++e) { um2[e] = um1[e]; um1[e] = u[e]; }
        }
        float* cs = nullptr;
        if (samp) cs = a.out + O_CONVS + (size_t)(seg - 2048) * 1024 + c0;
        else if (pos == 2040) cs = a.out + O_CONVP + (size_t)(seg >> 8) * 1024 + c0;
        if (cs) { *(f32x4*)cs = (f32x4){um2[0], um2[1], um2[2], um2[3]}; *(f32x4*)(cs + 4) = (f32x4){um2[4], um2[5], um2[6], um2[7]};
                  *(f32x4*)(cs + 512) = (f32x4){um1[0], um1[1], um1[2], um1[3]}; *(f32x4*)(cs + 516) = (f32x4){um1[4], um1[5], um1[6], um1[7]}; }
    }
}

struct PcRegs { f32x2 cum[8]; unsigned qq[8], kk[8]; u32x4 vv[2], sv[4], gv[2]; };
__device__ __forceinline__ void pc_load(PcRegs& r, int item, const bf16_t* proj, const float* logf, const bf16_t* St, int tid, int wid) {
    const int h = item & 3, n = (item >> 2) & 31, b = item >> 7, kp = tid & 63;
    const size_t row0 = (size_t)b * 2048 + n * 64;
#pragma unroll
    for (int q = 0; q < 8; ++q) { const size_t row = row0 + wid * 8 + q;
        r.cum[q] = *(const f32x2*)(logf + row * 512 + h * 128 + 2 * kp);
        r.qq[q] = *(const unsigned*)(proj + row * NIN + h * 128 + 2 * kp); r.kk[q] = *(const unsigned*)(proj + row * NIN + 512 + h * 128 + 2 * kp); }
    { const int s = tid >> 3, ch = tid & 7; const bf16_t* vp = proj + (row0 + s) * NIN + 1024 + h * 128 + ch * 16;
      r.vv[0] = *(const u32x4*)vp; r.vv[1] = *(const u32x4*)(vp + 8); r.gv[0] = *(const u32x4*)(vp + 512); r.gv[1] = *(const u32x4*)(vp + 520); }
#pragma unroll
    for (int i = 0; i < 4; ++i) { const int c = tid + 512 * i, v = c >> 4, kc = c & 15; r.sv[i] = *(const u32x4*)(St + (size_t)item * 16384 + v * 128 + kc * 8); }
}
__device__ __forceinline__ void passc_run(const Args& a, LAS unsigned char* lds) {
    const int tid = threadIdx.x, lane = tid & 63, wid = __builtin_amdgcn_readfirstlane(tid >> 6), fr = lane & 15, fq = lane >> 4;
    const bf16_t* proj = (const bf16_t*)(a.ws + WS_PROJ); const float* logf = (const float*)(a.ws + WS_LOGF); const bf16_t* St = (const bf16_t*)(a.ws + WS_ST); bf16_t* mix = (bf16_t*)(a.ws + WS_H);
    constexpr int RS = 272, PS = 144;
    LAS unsigned char* QD = lds; LAS unsigned char* KD = lds + 17408; LAS unsigned char* VS = lds + 34816; LAS unsigned char* SV = lds + 52224; LAS unsigned char* PP = lds + 87040;
    LAS float* SEG = (LAS float*)(lds + 96256); LAS float* SSQ = (LAS float*)(lds + 100352); LAS unsigned char* GS = lds + 100864;
    const int kp = tid & 63, sg = wid, tt = wid & 3, hh = wid >> 2;
    int item = blockIdx.x;
    if (item >= 1024) return;
    PcRegs R; pc_load(R, item, proj, logf, St, tid, wid);
    for (;;) {
        const int nitem = item + (int)gridDim.x;
        const int h = item & 3, n = (item >> 2) & 31, b = item >> 7;
        const size_t row0 = (size_t)b * 2048 + n * 64;
#pragma unroll
        for (int r = 1; r < 8; ++r) R.cum[r] += R.cum[r - 1];
        *(LAS f32x2*)(SEG + sg * 128 + 2 * kp) = R.cum[7];
        { const int s = tid >> 3, ch = tid & 7;
          *(LAS u32x4*)(VS + s * RS + ch * 32) = R.vv[0]; *(LAS u32x4*)(VS + s * RS + ch * 32 + 16) = R.vv[1];
          *(LAS u32x4*)(GS + s * RS + ch * 32) = R.gv[0]; *(LAS u32x4*)(GS + s * RS + ch * 32 + 16) = R.gv[1]; }
#pragma unroll
        for (int i = 0; i < 4; ++i) { const int c = tid + 512 * i, v = c >> 4, kc = c & 15; *(LAS u32x4*)(SV + v * RS + kc * 16) = R.sv[i]; }
        __syncthreads();
        { f32x2 off = (f32x2){0.f, 0.f};
          for (int j = 0; j < sg; ++j) off += *(const LAS f32x2*)(SEG + j * 128 + 2 * kp);
#pragma unroll
          for (int r = 0; r < 8; ++r) { const f32x2 c = R.cum[r] + off; const int s = sg * 8 + r;
              *(LAS unsigned*)(QD + s * RS + 4 * kp) = pk2(bflo(R.qq[r]) * __expf(c.x), bfhi(R.qq[r]) * __expf(c.y));
              *(LAS unsigned*)(KD + s * RS + 4 * kp) = pk2(bflo(R.kk[r]) * __expf(-c.x), bfhi(R.kk[r]) * __expf(-c.y)); } }
        if (nitem < 1024) pc_load(R, nitem, proj, logf, St, tid, wid);
        __syncthreads();
        bf16x8 aq[4];
#pragma unroll
        for (int k4 = 0; k4 < 4; ++k4) aq[k4] = *(const LAS bf16x8*)(QD + (16 * tt + fr) * RS + (32 * k4 + 8 * fq) * 2);
#pragma unroll
        for (int si = 0; si < 2; ++si) { const int st = hh * 2 + si;
            f32x4 acc = (f32x4){0.f, 0.f, 0.f, 0.f};
            if (st <= tt) {
#pragma unroll
                for (int k4 = 0; k4 < 4; ++k4) { const bf16x8 bk = *(const LAS bf16x8*)(KD + (16 * st + fr) * RS + (32 * k4 + 8 * fq) * 2);
                    acc = __builtin_amdgcn_mfma_f32_16x16x32_bf16(aq[k4], bk, acc, 0, 0, 0); }
            }
#pragma unroll
            for (int j = 0; j < 4; ++j) { const int t = 16 * tt + 4 * fq + j, s = 16 * st + fr; const float val = (t >= s) ? acc[j] : 0.f;
                *(LAS bf16_t*)(PP + t * PS + s * 2) = (bf16_t)(pk2(val, 0.f) & 0xffffu); } }
        __syncthreads();
        bf16x8 ap[2];
#pragma unroll
        for (int ss = 0; ss < 2; ++ss) ap[ss] = *(const LAS bf16x8*)(PP + (16 * tt + fr) * PS + (32 * ss + 8 * fq) * 2);
        f32x4 o[4];
#pragma unroll
        for (int i = 0; i < 4; ++i) { const int vt = hh * 4 + i;
            f32x4 acc = (f32x4){0.f, 0.f, 0.f, 0.f};
#pragma unroll
            for (int ss = 0; ss < 2; ++ss) { const bf16x8 bv = tr_frag(VS, RS, 32 * ss, 16 * vt, lane); acc = __builtin_amdgcn_mfma_f32_16x16x32_bf16(ap[ss], bv, acc, 0, 0, 0); }
#pragma unroll
            for (int k4 = 0; k4 < 4; ++k4) { const bf16x8 bs = *(const LAS bf16x8*)(SV + (16 * vt + fr) * RS + (32 * k4 + 8 * fq) * 2);
                acc = __builtin_amdgcn_mfma_f32_16x16x32_bf16(aq[k4], bs, acc, 0, 0, 0); }
            o[i] = acc; }
#pragma unroll
        for (int j = 0; j < 4; ++j) { float s = 0.f;
#pragma unroll
            for (int i = 0; i < 4; ++i) s += o[i][j] * o[i][j];
            s += __shfl_xor(s, 1); s += __shfl_xor(s, 2); s += __shfl_xor(s, 4); s += __shfl_xor(s, 8);
            if (fr == 0) SSQ[(16 * tt + 4 * fq + j) * 2 + hh] = s; }
        __syncthreads();
        const float* gon = a.in[11] + h * 128;
#pragma unroll
        for (int j = 0; j < 4; ++j) { const int t = 16 * tt + 4 * fq + j;
            const float rstd = rsqrtf((SSQ[t * 2] + SSQ[t * 2 + 1]) * (1.0f / 128.0f) + EPS);
#pragma unroll
            for (int i = 0; i < 4; ++i) { const int v = 16 * (hh * 4 + i) + fr;
                const float g = bf2f(*(const LAS bf16_t*)(GS + t * RS + v * 2));
                *(LAS bf16_t*)(QD + t * RS + v * 2) = (bf16_t)(pk2(o[i][j] * rstd * gon[v] * silu_f(g), 0.f) & 0xffffu); } }
        __syncthreads();
        { const int t = tid >> 3, ch = tid & 7; bf16_t* mp = mix + (row0 + t) * D + h * 128 + ch * 16;
          *(u32x4*)mp = *(const LAS u32x4*)(QD + t * RS + ch * 32); *(u32x4*)(mp + 8) = *(const LAS u32x4*)(QD + t * RS + ch * 32 + 16); }
        item = nitem;
        if (item >= 1024) break;
        __syncthreads();
    }
}

#define XB_TMO      128
#define XB_XCNT(j)  (256  + 64 * (j))
#define XB_XSUB(j)  (1280 + 64 * (j))
#define XB_XGEN(j)  (2304 + 64 * (j))
#define XB_TOP      3328
#define XB_TOPGEN   3392
#define XCD_BAR_WORDS 3456
#define XB_SPIN_CAP (1u << 18)
__device__ __forceinline__ unsigned xb_ld(unsigned* p)              { return __hip_atomic_load(p, __ATOMIC_RELAXED, __HIP_MEMORY_SCOPE_AGENT); }
__device__ __forceinline__ unsigned xb_add(unsigned* p, unsigned v) { return __hip_atomic_fetch_add(p, v, __ATOMIC_RELAXED, __HIP_MEMORY_SCOPE_AGENT); }
__device__ __forceinline__ unsigned xb_xcc_id() { return (unsigned)__builtin_amdgcn_s_getreg((3 << 11) | 20) & 0xFu; }
#define XB_SPIN(cond, bar) do { unsigned _sp = 0; while (cond) { __builtin_amdgcn_s_sleep(1); \
    if ((++_sp & 255u) == 0u) { if (xb_ld(&(bar)[XB_TMO])) break; if (_sp > XB_SPIN_CAP) { atomicAdd(&(bar)[XB_TMO], 1u); break; } } } } while (0)
struct XcdBarrier { unsigned* bar; unsigned x; volatile LAS unsigned* st; };
__device__ __forceinline__ XcdBarrier xcd_barrier_post(unsigned* bar, volatile LAS unsigned* st) {
    XcdBarrier b; b.bar = bar; b.x = xb_xcc_id(); b.st = st;
    if (threadIdx.x == 0) (void)xb_add(&bar[XB_XCNT(b.x)], 1u);
    return b;
}
__device__ __forceinline__ void xcd_barrier_complete(unsigned* bar, unsigned x, unsigned& nloc, unsigned& nx) {
    const unsigned G = gridDim.x * gridDim.y * gridDim.z;
    unsigned sum, cnt, mine, sp = 0u;
    for (;;) {
        sum = 0u; cnt = 0u; mine = 0u;
#pragma unroll
        for (unsigned j = 0; j < 16; ++j) { const unsigned c = xb_ld(&bar[XB_XCNT(j)]); sum += c; cnt += (c > 0u) ? 1u : 0u; mine = (j == x) ? c : mine; }
        if (sum == G) break;
        __builtin_amdgcn_s_sleep(1);
        if ((++sp & 255u) == 0u) { if (xb_ld(&bar[XB_TMO])) break; if (sp > XB_SPIN_CAP) { atomicAdd(&bar[XB_TMO], 1u); break; } }
    }
    nloc = mine > 0u ? mine : 1u; nx = cnt > 0u ? cnt : 1u;
}
__device__ __forceinline__ void xcd_barrier(const XcdBarrier& b) {
    asm volatile("s_waitcnt vmcnt(0)" ::: "memory");
    __syncthreads();
    if (threadIdx.x == 0) {
        unsigned* bar = b.bar;
        __builtin_amdgcn_s_waitcnt(0);
        unsigned nloc = b.st[0], nx = b.st[1];
        if (nloc == 0u) { xcd_barrier_complete(bar, b.x, nloc, nx); b.st[0] = nloc; b.st[1] = nx; }
        const unsigned old = xb_add(&bar[XB_XSUB(b.x)], 1u);
        const unsigned gen = old / nloc;
        if (old + 1u == (gen + 1u) * nloc) {
            __builtin_amdgcn_fence(__ATOMIC_RELEASE, "agent");
            asm volatile("s_waitcnt vmcnt(0)" ::: "memory");
            const unsigned og = xb_add(&bar[XB_TOP], 1u);
            const unsigned tg = og / nx;
            if (og + 1u == (tg + 1u) * nx) xb_add(&bar[XB_TOPGEN], 1u);
            else XB_SPIN(xb_ld(&bar[XB_TOPGEN]) == tg, bar);
            __builtin_amdgcn_fence(__ATOMIC_ACQUIRE, "agent");
            xb_add(&bar[XB_XGEN(b.x)], 1u);
            asm volatile("s_waitcnt vmcnt(0)" ::: "memory");
        } else {
            XB_SPIN(xb_ld(&bar[XB_XGEN(b.x)]) == gen, bar);
            __builtin_amdgcn_fence(__ATOMIC_ACQUIRE, "agent");
            asm volatile("s_waitcnt vmcnt(0)" ::: "memory");
        }
    }
    __syncthreads();
}

constexpr int N_PHASES = 11;
__global__ void __launch_bounds__(512, 2) fwd_megakernel(Args args) {
    extern __shared__ __attribute__((aligned(16))) unsigned char lds_raw[];
    LAS unsigned char* lds = (LAS unsigned char*)lds_raw;
    const int lo = args.ph_lo, hi = args.ph_hi;
    unsigned char* ws = args.ws;
    volatile LAS unsigned* xst = (volatile LAS unsigned*)(lds + LDS_MAIN);
    if (threadIdx.x < 4) xst[threadIdx.x] = 0u;
    __syncthreads();
    XcdBarrier xbar = xcd_barrier_post((unsigned*)(ws + WS_CTL), xst);
    if (hi < 0) cg::this_grid().sync();
    float* mod = (float*)(ws + WS_MOD);
#define IN(k) (lo <= (k) && (k) < hi)
#define SYNC_AFTER(k) do { if (IN(k) && IN((k) + 1)) xcd_barrier(xbar); } while (0)
#ifdef PROBE_SYNCS
    for (int i_ = 0; i_ < PROBE_SYNCS; ++i_) xcd_barrier(xbar);
#endif
    if (IN(0)) for (int rep_ = 0; rep_ <= ((PROBE_MASK >> 0) & 1); ++rep_) { if (rep_) xcd_barrier(xbar); phase_prep(args, lds); }
    SYNC_AFTER(0);
    if (IN(1)) for (int rep_ = 0; rep_ <= ((PROBE_MASK >> 1) & 1); ++rep_) { if (rep_) xcd_barrier(xbar); phase_mod(args, lds); }
    SYNC_AFTER(1);
    if (IN(2)) for (int rep_ = 0; rep_ <= ((PROBE_MASK >> 2) & 1); ++rep_) { if (rep_) xcd_barrier(xbar); phase_norm_mod(args.in[0], args.in[1], mod, 0, 1024, (bf16_t*)(ws + WS_H)); }
    SYNC_AFTER(2);
    if (IN(3)) for (int rep_ = 0; rep_ <= ((PROBE_MASK >> 3) & 1); ++rep_) { if (rep_) xcd_barrier(xbar);
        pg8::Gemm g{(const bf16_t*)(ws + WS_H), (const bf16_t*)(ws + WS_WIN), MT, NIN, D}; pg8::StaticOrder S; S.init(MT, NIN, (int)gridDim.x, (int)blockIdx.x);
        EpiIn E{(bf16_t*)(ws + WS_PROJ), (float*)(ws + WS_LOGF), (const float*)(ws + WS_LBS)};
        pg8::gemm_phase<EpiIn, pg8::StaticOrder, true, true>(lds, g, S, E);
    }
    SYNC_AFTER(3);
    if (IN(4)) for (int rep_ = 0; rep_ <= ((PROBE_MASK >> 4) & 1); ++rep_) { if (rep_) xcd_barrier(xbar);
        for (int item = blockIdx.x; item < 256; item += gridDim.x) {
            if (item < 128) scan_item(item, args, lds);
            else { for (int i = 0; i < 4; ++i) sample_pair((item - 128) * 4 + i, args, lds); }
        }
        conv_tasks(args);
    }
    SYNC_AFTER(4);
    if (IN(5)) for (int rep_ = 0; rep_ <= ((PROBE_MASK >> 5) & 1); ++rep_) { if (rep_) xcd_barrier(xbar); passc_run(args, lds); }
    SYNC_AFTER(5);
    if (IN(6)) for (int rep_ = 0; rep_ <= ((PROBE_MASK >> 6) & 1); ++rep_) { if (rep_) xcd_barrier(xbar);
        pg8::Gemm g{(const bf16_t*)(ws + WS_H), (const bf16_t*)(ws + WS_WOUT), MT, D, D}; pg8::StaticOrder S; S.init(MT, D, (int)gridDim.x, (int)blockIdx.x);
        EpiRes E{args.in[0], args.in[1], args.out + O_Y, mod + 2048};
        pg8::gemm_phase<EpiRes, pg8::StaticOrder, true, true>(lds, g, S, E);
    }
    SYNC_AFTER(6);
    if (IN(7)) for (int rep_ = 0; rep_ <= ((PROBE_MASK >> 7) & 1); ++rep_) { if (rep_) xcd_barrier(xbar); phase_norm_mod(args.out + O_Y, args.out + O_Y + (size_t)NTP * D, mod, 3072, 4096, (bf16_t*)(ws + WS_H)); }
    SYNC_AFTER(7);
    if (IN(8)) for (int rep_ = 0; rep_ <= ((PROBE_MASK >> 8) & 1); ++rep_) { if (rep_) xcd_barrier(xbar);
        pg8::Gemm g{(const bf16_t*)(ws + WS_H), (const bf16_t*)(ws + WS_WUP), MT, FF, D}; pg8::StaticOrder S; S.init(MT, FF, (int)gridDim.x, (int)blockIdx.x);
        EpiUp E{(bf16_t*)(ws + WS_U)};
        pg8::gemm_phase<EpiUp, pg8::StaticOrder, true, true>(lds, g, S, E);
    }
    SYNC_AFTER(8);
    if (IN(9)) for (int rep_ = 0; rep_ <= ((PROBE_MASK >> 9) & 1); ++rep_) { if (rep_) xcd_barrier(xbar);
        pg8::Gemm g{(const bf16_t*)(ws + WS_U), (const bf16_t*)(ws + WS_WDN), MT, D, FF}; pg8::StaticOrder S; S.init(MT, D, (int)gridDim.x, (int)blockIdx.x);
        EpiRes E{args.out + O_Y, args.out + O_Y + (size_t)NTP * D, args.out + O_Y, mod + 5120};
        pg8::gemm_phase<EpiRes, pg8::StaticOrder, true, true>(lds, g, S, E);
    }
    SYNC_AFTER(9);
    if (IN(10)) for (int rep_ = 0; rep_ <= ((PROBE_MASK >> 10) & 1); ++rep_) { if (rep_) xcd_barrier(xbar); phase_final(args.out + O_Y, args.in[15]); }
#undef IN
#undef SYNC_AFTER
}

extern "C" void kernel_launch(void* const* d_in, const int* in_sizes, int n_in, void* d_out, int out_size, void* d_ws, size_t ws_size, hipStream_t stream) {
    static int grid = 0;
    if (grid == 0) {
        if (n_in != 16 || ws_size < WS_END) { fprintf(stderr, "kernel_launch: unexpected n_in %d / ws_size %zu\n", n_in, ws_size); grid = -1; return; }
        int dev = 0, cus = 0, per_cu = 0;
        hipGetDevice(&dev); hipDeviceGetAttribute(&cus, hipDeviceAttributeMultiprocessorCount, dev);
        if (hipFuncSetAttribute((const void*)fwd_megakernel, hipFuncAttributeMaxDynamicSharedMemorySize, LDS_BYTES) != hipSuccess) { fprintf(stderr, "kernel_launch: hipFuncSetAttribute failed\n"); grid = -1; return; }
        if (hipOccupancyMaxActiveBlocksPerMultiprocessor(&per_cu, (const void*)fwd_megakernel, 512, LDS_BYTES) != hipSuccess || per_cu < 1) { fprintf(stderr, "kernel_launch: occupancy query gave %d\n", per_cu); per_cu = 1; }
        (void)hipGetLastError();
        grid = cus * 1;
    }
    if (grid < 0) return;
    Args a{};
    for (int i = 0; i < 16; ++i) a.in[i] = (const float*)d_in[i];
    a.out = (float*)d_out; a.ws = (unsigned char*)d_ws;
    if (hipMemsetAsync((char*)d_ws + WS_CTL, 0, CTL_BYTES, stream) != hipSuccess) { fprintf(stderr, "kernel_launch: memset failed\n"); return; }
#if ONE_LAUNCH
    a.ph_lo = 0; a.ph_hi = N_PHASES;
    void* kargs[] = {&a};
    hipError_t e = hipLaunchCooperativeKernel((const void*)fwd_megakernel, dim3(grid), dim3(512), kargs, LDS_BYTES, stream);
    if (e != hipSuccess) fprintf(stderr, "cooperative launch failed: %s (grid %d)\n", hipGetErrorString(e), grid);
#else
    for (int p = 0; p < N_PHASES; ++p) { a.ph_lo = p; a.ph_hi = p + 1; hipLaunchKernelGGL(fwd_megakernel, dim3(grid), dim3(512), LDS_BYTES, stream, a); }
#endif
}
```
